# Optimizing an MI355X kernel written in HIP

```python
import math, functools
import jax, jax.numpy as jnp
from jax import lax
import numpy as np

D_MODEL = 1024
BATCH = 16
SEQ = 256
DEPTH = 2
DEC_BATCH = 8
DEC_SEQ = 2048
PAST_LEN = 512

GRID_W = 64
D_MIX = D_MODEL
D_A = D_MIX // 4
A_HEADS = 4
A_HEAD_DIM = D_A // A_HEADS
CHUNK = 128
D_B = D_MIX // 4
B_GROUPS = 4
B_GROUP_DIM = D_B // B_GROUPS
D_C = D_MIX - D_A - D_B
C_HEAD_DIM = 64
C_HEADS = D_C // C_HEAD_DIM
P_IN = 2 * D_A + D_B + 3 * D_C
NA_ROWS = 8
NA_KW = 16
NA_QB = 16
NA_BAND = NA_QB + NA_KW
ATTN_QBLK = 128
D_FF = 2816
CONV_W = 3
ALPHA = (2 * DEPTH) ** 0.25
BETA = (8 * DEPTH) ** -0.25
LN_EPS = 1e-6

kernel_name = "hybrid_gmlp_fnet_natten_diffusion_step"


def _norm(x):
    xf = x.astype(jnp.float32)
    mu = xf.mean(-1, keepdims=True)
    var = jnp.square(xf - mu).mean(-1, keepdims=True)
    return ((xf - mu) * lax.rsqrt(var + LN_EPS)).astype(x.dtype)


def _affine_ln(x, g, b):
    return _norm(x) * g + b


def _chunk_gmlp(z, ws, bs):
    B, L, _ = z.shape
    z = jax.nn.gelu(z)
    u, v = jnp.split(z, 2, axis=-1)
    v = _norm(v).reshape(B, L // CHUNK, CHUNK, A_HEADS, A_HEAD_DIM)
    v = jnp.einsum('hpq,bnqhd->bnphd', ws, v) + bs.T[None, None, :, :, None]
    return u * v.reshape(B, L, D_A)


def _fourier(z, fw):
    B, L, _ = z.shape
    zg = z.reshape(B, L, B_GROUPS, B_GROUP_DIM).astype(jnp.float32)
    zf = jnp.fft.fft2(zg, axes=(1, 3), norm='ortho').real.astype(z.dtype)
    return jnp.einsum('blgc,gcd->blgd', zf, fw).reshape(B, L, D_B)


def _conv_ffn(h, w_gu, conv_w, conv_b, w_down):
    g, u = jnp.split(h @ w_gu, 2, axis=-1)
    L = g.shape[1]
    pad = CONV_W // 2
    gp = jnp.pad(g, ((0, 0), (pad, pad), (0, 0)))
    gc = conv_b
    for t in range(CONV_W):
        gc = gc + gp[:, t:t + L] * conv_w[t]
    return (jax.nn.silu(gc) * u) @ w_down


def _context_attention(q, k, v):
    B, L, H, d = q.shape
    scale = d ** -0.5
    qb = q.reshape(B, L // ATTN_QBLK, ATTN_QBLK, H, d).transpose(1, 0, 2, 3, 4)

    def blk(qi):
        s = jnp.einsum('bqhd,bkhd->bhqk', qi, k).astype(jnp.float32) * scale
        p = jax.nn.softmax(s, axis=-1).astype(v.dtype)
        return jnp.einsum('bhqk,bkhd->bqhd', p, v)

    o = lax.map(blk, qb)
    return o.transpose(1, 0, 2, 3, 4).reshape(B, L, H * d)


def _neighbourhood_attention(q, k, v, kc, vc, rpb):
    B, L, H, d = q.shape
    R = L // GRID_W
    kh = min(NA_ROWS, R)
    scale = d ** -0.5
    nb = GRID_W // NA_QB
    cols = np.arange(GRID_W)
    col_start = np.clip(cols - NA_KW // 2, 0, GRID_W - NA_KW).reshape(nb, NA_QB)
    band_start = np.clip(np.arange(nb) * NA_QB - NA_KW // 2, 0, GRID_W - NA_BAND)
    band_cols = band_start[:, None] + np.arange(NA_BAND)
    qcols = cols.reshape(nb, NA_QB)
    kcols = band_cols[:, None, :]
    in_win = (kcols >= col_start[:, :, None]) & (kcols < col_start[:, :, None] + NA_KW)
    col_idx = np.clip(kcols - qcols[:, :, None] + NA_KW - 1, 0, 2 * NA_KW - 2)
    mask = in_win[:, :, None, :]
    qg = q.reshape(B, R, GRID_W, H, d)
    kg = k.reshape(B, R, GRID_W, H, d)
    vg = v.reshape(B, R, GRID_W, H, d)
    n_loc = kh * NA_BAND

    def row(r):
        rs = jnp.clip(r - kh // 2, 0, R - kh)
        kr = lax.dynamic_slice_in_dim(kg, rs, kh, axis=1)
        vr = lax.dynamic_slice_in_dim(vg, rs, kh, axis=1)
        kb = kr[:, :, band_cols]
        vb = vr[:, :, band_cols]
        qr = lax.dynamic_index_in_dim(qg, r, axis=1, keepdims=False).reshape(B, nb, NA_QB, H, d)
        row_idx = rs + jnp.arange(kh) - r + NA_ROWS - 1
        bias = rpb[:, row_idx][:, :, col_idx].transpose(0, 2, 3, 1, 4)
        s_loc = jnp.einsum('bjqhd,bkjwhd->bhjqkw', qr, kb).astype(jnp.float32) * scale
        s_loc = jnp.where(mask, s_loc + bias.astype(jnp.float32)[None], -jnp.inf)
        s_loc = s_loc.reshape(B, H, nb, NA_QB, n_loc)
        s_ctx = jnp.einsum('bjqhd,bchd->bhjqc', qr, kc).astype(jnp.float32) * scale
        p = jax.nn.softmax(jnp.concatenate([s_loc, s_ctx], axis=-1), axis=-1).astype(v.dtype)
        p_loc = p[..., :n_loc].reshape(B, H, nb, NA_QB, kh, NA_BAND)
        p_ctx = p[..., n_loc:]
        o = (jnp.einsum('bhjqkw,bkjwhd->bjqhd', p_loc, vb)
             + jnp.einsum('bhjqc,bchd->bjqhd', p_ctx, vc))
        return o.reshape(B, GRID_W, H * d)

    o = lax.map(row, jnp.arange(R))
    return o.transpose(1, 0, 2, 3).reshape(B, L, H * d)


def _layer(x, mod, w_in, a_ws, a_bs, f_w, w_out, ln1_g, ln1_b,
           w_gu, conv_w, conv_b, w_down, ln2_g, ln2_b, attend):
    shift1, scale1, gate1, shift2, scale2, gate2 = jnp.split(mod, 6, axis=-1)
    B, L, _ = x.shape
    h = _norm(x) * (1 + scale1) + shift1
    z = h @ w_in
    o1 = 2 * D_A
    o2 = o1 + D_B
    o3 = o2 + D_C
    o4 = o3 + D_C
    za, zb, q, k, v = jnp.split(z, [o1, o2, o3, o4], axis=-1)
    q = q.reshape(B, L, C_HEADS, C_HEAD_DIM)
    k = k.reshape(B, L, C_HEADS, C_HEAD_DIM)
    v = v.reshape(B, L, C_HEADS, C_HEAD_DIM)
    y = jnp.concatenate([_chunk_gmlp(za, a_ws, a_bs), _fourier(zb, f_w), attend(q, k, v)], axis=-1) @ w_out
    x = _affine_ln(ALPHA * x + gate1 * y, ln1_g, ln1_b)
    h = _norm(x) * (1 + scale2) + shift2
    x = _affine_ln(ALPHA * x + gate2 * _conv_ffn(h, w_gu, conv_w, conv_b, w_down), ln2_g, ln2_b)
    return x, k, v


def setup_inputs(seed: int = 0) -> dict:
    key = jax.random.key(seed)
    ks = jax.random.split(key, 24)
    n = lambda i, shape, s=1.0: jax.random.normal(ks[i], shape, jnp.float32) * s
    return {
        'x_prompt': n(0, (BATCH, SEQ, D_MODEL)),
        'x_sample': n(1, (DEC_BATCH, DEC_SEQ, D_MODEL)),
        'cache_k': n(2, (DEC_BATCH, DEPTH, PAST_LEN, C_HEADS, C_HEAD_DIM)),
        'cache_v': n(3, (DEC_BATCH, DEPTH, PAST_LEN, C_HEADS, C_HEAD_DIM)),
        'c': n(4, (DEC_BATCH, D_MODEL)),
        'c_ctx': n(5, (D_MODEL,)),
        'w_ada': n(6, (DEPTH, D_MODEL, 6 * D_MODEL), 0.5 * D_MODEL ** -0.5),
        'b_ada': n(7, (DEPTH, 6 * D_MODEL), 0.01),
        'w_in': n(8, (DEPTH, D_MODEL, P_IN), D_MODEL ** -0.5),
        'a_ws': n(9, (DEPTH, A_HEADS, CHUNK, CHUNK), CHUNK ** -0.5),
        'a_bs': 1.0 + n(10, (DEPTH, A_HEADS, CHUNK), 0.1),
        'f_w': n(11, (DEPTH, B_GROUPS, B_GROUP_DIM, B_GROUP_DIM), B_GROUP_DIM ** -0.5),
        'rpb': n(12, (DEPTH, C_HEADS, 2 * NA_ROWS - 1, 2 * NA_KW - 1), 0.5),
        'w_out': n(13, (DEPTH, D_MIX, D_MODEL), BETA * D_MIX ** -0.5),
        'ln1_g': 1.0 + n(14, (DEPTH, D_MODEL), 0.05),
        'ln1_b': n(15, (DEPTH, D_MODEL), 0.01),
        'w_gu': n(16, (DEPTH, D_MODEL, 2 * D_FF), D_MODEL ** -0.5),
        'conv_w': n(17, (DEPTH, CONV_W, D_FF), CONV_W ** -0.5),
        'conv_b': n(18, (DEPTH, D_FF), 0.01),
        'w_down': n(19, (DEPTH, D_FF, D_MODEL), BETA * D_FF ** -0.5),
        'ln2_g': 1.0 + n(20, (DEPTH, D_MODEL), 0.05),
        'ln2_b': n(21, (DEPTH, D_MODEL), 0.01),
    }


def reference(x_prompt, x_sample, cache_k, cache_v, c, c_ctx, w_ada, b_ada, w_in, a_ws, a_bs,
              f_w, rpb, w_out, ln1_g, ln1_b, w_gu, conv_w, conv_b, w_down, ln2_g, ln2_b):
    xp = x_prompt
    xs = x_sample
    new_ks = []
    new_vs = []
    for l in range(DEPTH):
        shared = (w_in[l], a_ws[l], a_bs[l], f_w[l], w_out[l], ln1_g[l], ln1_b[l],
                  w_gu[l], conv_w[l], conv_b[l], w_down[l], ln2_g[l], ln2_b[l])
        mod_ctx = (jax.nn.silu(c_ctx) @ w_ada[l] + b_ada[l])[None, None, :]
        xp, k_l, v_l = _layer(xp, mod_ctx, *shared, attend=_context_attention)
        new_ks.append(k_l)
        new_vs.append(v_l)
        mod_lat = (jax.nn.silu(c) @ w_ada[l] + b_ada[l])[:, None, :]
        attend_lat = functools.partial(_neighbourhood_attention, kc=cache_k[:, l], vc=cache_v[:, l], rpb=rpb[l])
        xs, _, _ = _layer(xs, mod_lat, *shared, attend=attend_lat)
    new_k = jnp.stack(new_ks, axis=1)
    new_v = jnp.stack(new_vs, axis=1)
    return (xp, xs, new_k, new_v)
```

```cpp
#include <hip/hip_runtime.h>
#include <cstdio>
#include <cstdint>
namespace pg8 {
#define PG8_LAS __attribute__((address_space(3)))
typedef unsigned short bf16_t;
typedef short bf16x8 __attribute__((ext_vector_type(8)));
typedef float f32x4 __attribute__((ext_vector_type(4)));
typedef unsigned u32x4 __attribute__((ext_vector_type(4)));
constexpr int BM = 256, BK = 64, HALF = 128, HTB = HALF * BK * 2  , STAGE_BYTES = 8 * HTB, NXCD = 8, WGM = 8;

__host__ __device__ __forceinline__ int lds_byte(int r, int c) { const int st = (r >> 4) * 2 + (c >> 5), rr = r & 15, cc = c & 31, ob = rr * 64 + cc * 2; return st * 1024 + (ob ^ (((ob >> 9) & 1) << 5)); }
__host__ __device__ __forceinline__ void stage_rc(int b, int& R, int& C) { const int st = b / 1024, sb = b % 1024, swz = sb ^ (((sb >> 9) & 1) << 5); R = (st >> 1) * 16 + swz / 64; C = (st & 1) * 32 + (swz % 64) / 2; }
__host__ __device__ __forceinline__ int perm32(int rho) { const int n = rho >> 4, i = rho & 15; return 8 * (i >> 2) + 4 * n + (i & 3); }

struct Unit { int pm, pn; };
struct Gemm { const bf16_t* A; const bf16_t* Bt; int M, N, K; };

struct StaticOrder {
    int nM, nN, nwg, G, c;
    __host__ __device__ void init(int M, int N, int G_, int c_) { nM = M / BM; nN = N / BM; nwg = nM * nN; G = G_; c = c_; }
    __host__ __device__ bool next(int i, Unit& u) const {
        const long L = (long)i * G + c; if (L >= nwg) return false;
        int wgid = (int)L; { const int q = nwg / NXCD, r = nwg % NXCD, xcd = wgid % NXCD, off = wgid / NXCD; wgid = (xcd < r ? xcd * (q + 1) : r * (q + 1) + (xcd - r) * q) + off; }
        const int nig = WGM * nN, gid = wgid / nig, fm = gid * WGM, gsz = (nM - fm) < WGM ? (nM - fm) : WGM;
        u.pm = fm + ((wgid % nig) % gsz); u.pn = (wgid % nig) / gsz; return true;
    }
    __device__ __forceinline__ void a_ready(const Unit&) const {}
    __device__ __forceinline__ void done(const Unit&) const {}
};
__device__ __forceinline__ unsigned cvt_pk_bf16(float lo, float hi) { unsigned r; asm volatile("v_cvt_pk_bf16_f32 %0, %1, %2" : "=v"(r) : "v"(lo), "v"(hi)); return r; }
template <class Epi, class Sched, bool ALIGN_EPI = false, bool SP2 = false>
__device__ __forceinline__ void gemm_phase(PG8_LAS unsigned char* lds, const Gemm g, const Sched& S, const Epi& E) {
    int tid = threadIdx.x; asm volatile("" : "+v"(tid));
    const int wid = __builtin_amdgcn_readfirstlane(tid >> 6), lane = tid & 63, wr = wid >> 2, wc = wid & 3, fr = lane & 15, fq = lane >> 4;
    const int K = g.K, nt = K / BK;
    unsigned voffA[2], voffB[2];
#pragma unroll
    for (int i = 0; i < 2; ++i) { int R, C; stage_rc(tid * 16 + i * 8192, R, C); const int Rb = Epi::PERM ? ((R & ~31) + perm32(R & 31)) : R;
        voffA[i] = (unsigned)(R * K + C) * 2u; voffB[i] = (unsigned)(Rb * K + C) * 2u; }
    const size_t kstep = (size_t)(BK * 2);
    const size_t hstep = (size_t)HALF * K * 2;
    const size_t tstep = 2 * hstep;
    const unsigned ldsw = (unsigned)wid * 1024u;
    const int aoff = lds_byte(wr * 64 + fr, fq * 8), boff = lds_byte(wc * 32 + fr, fq * 8);
#define PG8_SA(b, h) (((b) * 2 + (h)) * HTB)
#define PG8_SB(b, h) ((4 + (b) * 2 + (h)) * HTB)
#define PG8_STAGE(bufoff, gbase, voff) do { _Pragma("unroll") for (int _i = 0; _i < 2; ++_i) \
        __builtin_amdgcn_global_load_lds((const unsigned*)((const char*)(gbase) + (voff)[_i]), (PG8_LAS unsigned*)(lds + (bufoff) + ldsw + _i * 8192), 16, 0, 0); } while (0)
#define PG8_LDA(dst, b, h) do { _Pragma("unroll") for (int m = 0; m < 4; ++m) _Pragma("unroll") for (int k = 0; k < 2; ++k) dst[m][k] = *(const PG8_LAS bf16x8*)(lds + PG8_SA(b, h) + aoff + m * 2048 + k * 1024); } while (0)
#define PG8_LDB(dst, b, h) do { _Pragma("unroll") for (int n = 0; n < 2; ++n) _Pragma("unroll") for (int k = 0; k < 2; ++k) dst[n][k] = *(const PG8_LAS bf16x8*)(lds + PG8_SB(b, h) + boff + n * 2048 + k * 1024); } while (0)
#define PG8_MMA(ai, bj, At, Bt) do { __builtin_amdgcn_s_setprio(1); _Pragma("unroll") for (int m = 0; m < 4; ++m) _Pragma("unroll") for (int n = 0; n < 2; ++n) _Pragma("unroll") for (int k = 0; k < 2; ++k) \
        acc[ai][bj][m][n] = __builtin_amdgcn_mfma_f32_16x16x32_bf16(Bt[n][k], At[m][k], acc[ai][bj][m][n], 0, 0, 0); __builtin_amdgcn_s_setprio(0); } while (0)
#define PG8_WAIT_V(n) asm volatile("s_waitcnt vmcnt(" #n ")" ::: "memory")
#define PG8_WAIT_L(n) asm volatile("s_waitcnt lgkmcnt(" #n ")" ::: "memory")
#define PG8_BAR __builtin_amdgcn_s_barrier()
#define PG8_SCHED __builtin_amdgcn_sched_barrier(0)
    Unit cur, nxt; int ui = 0;
    if (!S.next(0, cur)) return;
    f32x4 acc[2][2][4][2];
#pragma unroll
    for (int a = 0; a < 2; ++a)
#pragma unroll
        for (int b = 0; b < 2; ++b)
#pragma unroll
            for (int m = 0; m < 4; ++m)
#pragma unroll
                for (int n = 0; n < 2; ++n) acc[a][b][m][n] = (f32x4){0.f, 0.f, 0.f, 0.f};
    bf16x8 At[4][2], B0[2][2], B1[2][2];
    const char* cA = (const char*)g.A + (size_t)cur.pm * tstep; const char* cB = (const char*)g.Bt + (size_t)cur.pn * tstep;
    S.a_ready(cur);
    if constexpr (SP2) {
        PG8_STAGE(PG8_SB(0, 0), cB, voffB); PG8_STAGE(PG8_SB(0, 1), cB + hstep, voffB); PG8_STAGE(PG8_SA(0, 0), cA, voffA); PG8_STAGE(PG8_SA(0, 1), cA + hstep, voffA);
        if (wr == 1) PG8_BAR;
        PG8_WAIT_V(2); PG8_BAR;
        PG8_STAGE(PG8_SB(1, 0), cB + kstep, voffB); PG8_STAGE(PG8_SA(1, 0), cA + kstep, voffA); PG8_STAGE(PG8_SB(1, 1), cB + hstep + kstep, voffB);
        PG8_WAIT_V(6); PG8_BAR;
    } else {
        PG8_STAGE(PG8_SB(0, 0), cB, voffB); PG8_STAGE(PG8_SA(0, 0), cA, voffA); PG8_STAGE(PG8_SB(0, 1), cB + hstep, voffB); PG8_STAGE(PG8_SA(0, 1), cA + hstep, voffA);
        if (wr == 1) PG8_BAR;
        PG8_WAIT_V(4); PG8_BAR;
        PG8_STAGE(PG8_SB(1, 0), cB + kstep, voffB); PG8_STAGE(PG8_SA(1, 0), cA + kstep, voffA); PG8_STAGE(PG8_SB(1, 1), cB + hstep + kstep, voffB);
        PG8_WAIT_V(6); PG8_BAR;
    }
    for (;;) {
        const bool has_next = S.next(ui + 1, nxt);
        const char* nA = has_next ? (const char*)g.A + (size_t)nxt.pm * tstep : cA; const char* nB = has_next ? (const char*)g.Bt + (size_t)nxt.pn * tstep : cB;
        for (int t = 0; t < nt; t += 2) {
            const bool last = (t == nt - 2);
            const char* a1 = cA + (size_t)(t + 1) * kstep;
            const char* a2 = last ? nA : cA + (size_t)(t + 2) * kstep; const char* b2 = last ? nB : cB + (size_t)(t + 2) * kstep;
            const char* a3 = a2 + kstep; const char* b3 = b2 + kstep;
            if (last && has_next) S.a_ready(nxt);
            if constexpr (SP2) {
            PG8_LDB(B0, 0, 0); PG8_LDB(B1, 0, 1); PG8_SCHED; PG8_LDA(At, 0, 0); PG8_STAGE(PG8_SA(1, 1), a1 + hstep, voffA);
            PG8_WAIT_V(8); PG8_WAIT_L(0); PG8_BAR; PG8_MMA(0, 0, At, B0); PG8_MMA(0, 1, At, B1); PG8_BAR; PG8_SCHED;
            PG8_LDA(At, 0, 1); PG8_STAGE(PG8_SB(0, 0), b2, voffB); PG8_STAGE(PG8_SB(0, 1), b2 + hstep, voffB); PG8_STAGE(PG8_SA(0, 0), a2, voffA);
            PG8_WAIT_V(8); PG8_WAIT_L(0); PG8_BAR; PG8_MMA(1, 0, At, B0); PG8_MMA(1, 1, At, B1); PG8_BAR; PG8_SCHED;
            PG8_LDB(B0, 1, 0); PG8_LDB(B1, 1, 1); PG8_SCHED; PG8_LDA(At, 1, 0); PG8_STAGE(PG8_SA(0, 1), a2 + hstep, voffA);
            PG8_WAIT_V(8); PG8_WAIT_L(0); PG8_BAR; PG8_MMA(0, 0, At, B0); PG8_MMA(0, 1, At, B1); PG8_BAR; PG8_SCHED;
            PG8_LDA(At, 1, 1); PG8_STAGE(PG8_SB(1, 0), b3, voffB); PG8_STAGE(PG8_SB(1, 1), b3 + hstep, voffB); PG8_STAGE(PG8_SA(1, 0), a3, voffA);
            PG8_WAIT_V(8); PG8_WAIT_L(0); PG8_BAR; PG8_MMA(1, 0, At, B0); PG8_MMA(1, 1, At, B1); PG8_BAR; PG8_SCHED;
            } else {
            PG8_LDB(B0, 0, 0); PG8_SCHED; PG8_LDA(At, 0, 0); PG8_STAGE(PG8_SA(1, 1), a1 + hstep, voffA);
            PG8_WAIT_L(8); PG8_BAR; PG8_WAIT_L(0); PG8_MMA(0, 0, At, B0); PG8_BAR; PG8_SCHED;
            PG8_LDB(B1, 0, 1); PG8_STAGE(PG8_SB(0, 0), b2, voffB);
            PG8_BAR; PG8_WAIT_L(0); PG8_MMA(0, 1, At, B1); PG8_BAR;
            PG8_LDA(At, 0, 1); PG8_STAGE(PG8_SA(0, 0), a2, voffA);
            PG8_BAR; PG8_WAIT_L(0); PG8_MMA(1, 0, At, B0); PG8_BAR; PG8_SCHED;
            PG8_STAGE(PG8_SB(0, 1), b2 + hstep, voffB);
            PG8_WAIT_V(6); PG8_BAR; PG8_MMA(1, 1, At, B1); PG8_BAR;
            PG8_LDB(B0, 1, 0); PG8_SCHED; PG8_LDA(At, 1, 0); PG8_STAGE(PG8_SA(0, 1), a2 + hstep, voffA);
            PG8_WAIT_L(8); PG8_BAR; PG8_WAIT_L(0); PG8_MMA(0, 0, At, B0); PG8_BAR; PG8_SCHED;
            PG8_LDB(B1, 1, 1); PG8_STAGE(PG8_SB(1, 0), b3, voffB);
            PG8_BAR; PG8_WAIT_L(0); PG8_MMA(0, 1, At, B1); PG8_BAR;
            PG8_LDA(At, 1, 1); PG8_STAGE(PG8_SA(1, 0), a3, voffA);
            PG8_BAR; PG8_WAIT_L(0); PG8_MMA(1, 0, At, B0); PG8_BAR; PG8_SCHED;
            PG8_STAGE(PG8_SB(1, 1), b3 + hstep, voffB);
            PG8_WAIT_V(6); PG8_BAR; PG8_MMA(1, 1, At, B1); PG8_BAR;
            }
        }
        if constexpr (ALIGN_EPI) { if (wr == 0) PG8_BAR; }
        if constexpr (!Epi::AFTER_DRAIN) { E(acc, cur, wr, wc, fr, fq); S.done(cur); }
        if (!has_next) break;
#pragma unroll
        for (int a = 0; a < 2; ++a)
#pragma unroll
            for (int b = 0; b < 2; ++b)
#pragma unroll
                for (int m = 0; m < 4; ++m)
#pragma unroll
                    for (int n = 0; n < 2; ++n) acc[a][b][m][n] = (f32x4){0.f, 0.f, 0.f, 0.f};
        cur = nxt; cA = nA; cB = nB; ++ui;
        if constexpr (ALIGN_EPI) { if (wr == 1) PG8_BAR; }
    }
    PG8_WAIT_V(0);
    if constexpr (!ALIGN_EPI) { if (wr == 0) PG8_BAR; }
    PG8_BAR;
    if constexpr (Epi::AFTER_DRAIN) { E.fused(acc, cur, wr, wc, fr, fq, lds, wid, lane); S.done(cur); }
#undef PG8_SA
#undef PG8_SB
#undef PG8_STAGE
#undef PG8_LDA
#undef PG8_LDB
#undef PG8_MMA
#undef PG8_WAIT_V
#undef PG8_WAIT_L
#undef PG8_BAR
#undef PG8_SCHED
}
}
#ifndef PG8_SP2
#define PG8_SP2 true
#endif
#ifndef PG8_ALIGN
#define PG8_ALIGN true
#endif
#define GAS __attribute__((address_space(1)))
#define LAS __attribute__((address_space(3)))
typedef unsigned short bf16;
typedef unsigned v4u __attribute__((ext_vector_type(4)));
typedef float f32x4 __attribute__((ext_vector_type(4)));
typedef short bf16x8 __attribute__((ext_vector_type(8)));
typedef GAS unsigned gu32;
typedef GAS unsigned long long gu64;
#define RLX_AGENT __ATOMIC_RELAXED, __HIP_MEMORY_SCOPE_AGENT
#define LDS_WAIT() asm volatile("s_waitcnt lgkmcnt(0)" ::: "memory")
#define VM_WAIT() asm volatile("s_waitcnt vmcnt(0)" ::: "memory")
__device__ __forceinline__ unsigned long long rt() { return __builtin_amdgcn_s_memrealtime(); }
__device__ __forceinline__ unsigned f2bf(float f) { unsigned u = __builtin_bit_cast(unsigned, f); return (u + 0x7fffu + ((u >> 16) & 1u)) >> 16; }
__device__ __forceinline__ unsigned pk2(float lo, float hi) { return f2bf(lo) | (f2bf(hi) << 16); }

#define XB_TMO      128
#define XB_XCNT(j)  (256  + 64 * (j))
#define XB_XSUB(j)  (1280 + 64 * (j))
#define XB_XGEN(j)  (2304 + 64 * (j))
#define XB_TOP      3328
#define XB_TOPGEN   3392
#define XCD_BAR_WORDS 3456
#define XB_SPIN_CAP (1u << 18)

__device__ __forceinline__ unsigned xb_ld(unsigned* p)              { return __hip_atomic_load(p, __ATOMIC_RELAXED, __HIP_MEMORY_SCOPE_AGENT); }
__device__ __forceinline__ unsigned xb_add(unsigned* p, unsigned v) { return __hip_atomic_fetch_add(p, v, __ATOMIC_RELAXED, __HIP_MEMORY_SCOPE_AGENT); }
__device__ __forceinline__ unsigned xb_xcc_id() { return (unsigned)__builtin_amdgcn_s_getreg((3 << 11) | 20) & 0xFu; }
#define XB_SPIN(cond, bar) do { unsigned _sp = 0; while (cond) { __builtin_amdgcn_s_sleep(1); \
    if ((++_sp & 255u) == 0u) { if (xb_ld(&(bar)[XB_TMO])) break; if (_sp > XB_SPIN_CAP) { atomicAdd(&(bar)[XB_TMO], 1u); break; } } } } while (0)

struct XcdBarrier {
    unsigned* bar; unsigned x;
    volatile LAS unsigned* st;
};

__device__ __forceinline__ XcdBarrier xcd_barrier_post(unsigned* bar, volatile LAS unsigned* st) {
    XcdBarrier b; b.bar = bar; b.x = xb_xcc_id(); b.st = st;
    if (threadIdx.x == 0) (void)xb_add(&bar[XB_XCNT(b.x)], 1u);
    return b;
}
__device__ __forceinline__ void xcd_barrier_complete(unsigned* bar, unsigned x, unsigned& nloc, unsigned& nx) {
    const unsigned G = gridDim.x * gridDim.y * gridDim.z;
    unsigned sum, cnt, mine, sp = 0u;
    for (;;) {
        sum = 0u; cnt = 0u; mine = 0u;
#pragma unroll
        for (unsigned j = 0; j < 16; ++j) { const unsigned c = xb_ld(&bar[XB_XCNT(j)]); sum += c; cnt += (c > 0u) ? 1u : 0u; mine = (j == x) ? c : mine; }
        if (sum == G) break;
        __builtin_amdgcn_s_sleep(1);
        if ((++sp & 255u) == 0u) { if (xb_ld(&bar[XB_TMO])) break; if (sp > XB_SPIN_CAP) { atomicAdd(&bar[XB_TMO], 1u); break; } }
    }
    nloc = mine > 0u ? mine : 1u; nx = cnt > 0u ? cnt : 1u;
}

__device__ __forceinline__ void xcd_barrier(const XcdBarrier& b) {
    asm volatile("s_waitcnt vmcnt(0)" ::: "memory");
    __syncthreads();
    if (threadIdx.x == 0) {
        unsigned* bar = b.bar;
        __builtin_amdgcn_s_waitcnt(0);
        unsigned nloc = b.st[0], nx = b.st[1];
        if (nloc == 0u) { xcd_barrier_complete(bar, b.x, nloc, nx); b.st[0] = nloc; b.st[1] = nx; }
        const unsigned old = xb_add(&bar[XB_XSUB(b.x)], 1u);
        const unsigned gen = old / nloc;
        if (old + 1u == (gen + 1u) * nloc) {
            __builtin_amdgcn_fence(__ATOMIC_RELEASE, "agent");
            asm volatile("s_waitcnt vmcnt(0)" ::: "memory");
            const unsigned og = xb_add(&bar[XB_TOP], 1u);
            const unsigned tg = og / nx;
            if (og + 1u == (tg + 1u) * nx) xb_add(&bar[XB_TOPGEN], 1u);
            else XB_SPIN(xb_ld(&bar[XB_TOPGEN]) == tg, bar);
            __builtin_amdgcn_fence(__ATOMIC_ACQUIRE, "agent");
            xb_add(&bar[XB_XGEN(b.x)], 1u);
            asm volatile("s_waitcnt vmcnt(0)" ::: "memory");
        } else {
            XB_SPIN(xb_ld(&bar[XB_XGEN(b.x)]) == gen, bar);
            __builtin_amdgcn_fence(__ATOMIC_ACQUIRE, "agent");
            asm volatile("s_waitcnt vmcnt(0)" ::: "memory");
        }
    }
    __syncthreads();
}

constexpr int DM = 1024;
constexpr int MCTX = 4096, MLAT = 16384, MTOK = 20480;
constexpr int NZ = 2048;
constexpr int DFF = 2816, NGU = 5632, PIN = 2304;
constexpr int WIN_ROWS = 2560;
constexpr int MODW = 6144;
constexpr float LN_EPS = 1e-6f;
constexpr float ALPHA_RES = 1.41421356237309515f;
constexpr float LOG2E = 1.4426950408889634f;
constexpr float QSCALE = 0.125f * LOG2E;

constexpr size_t MiB = 1u << 20;
constexpr size_t WS_CTL = 0, CTL_ZERO_BYTES = 65536;
constexpr size_t WS_MOD = 1 * MiB;
constexpr size_t WS_AWS = 1 * MiB + 512 * 1024;
constexpr size_t WS_DFT256 = 1 * MiB + 768 * 1024;
constexpr size_t WS_WIN = 2 * MiB;
constexpr size_t WS_H = 12 * MiB;
constexpr size_t WS_WOUT = 52 * MiB;
constexpr size_t WS_WGU = 56 * MiB;
constexpr size_t WS_WDN = 78 * MiB;
constexpr size_t WS_DFT = 89 * MiB;
constexpr size_t WS_EDGE = 105 * MiB;
constexpr size_t WS_Z = 111 * MiB;
constexpr size_t WS_PQL = 191 * MiB;
constexpr size_t WS_PQC = 207 * MiB;
constexpr size_t WS_MIX = 211 * MiB;
constexpr size_t WS_ACT = 111 * MiB;
constexpr size_t WS_END = 251 * MiB;
static_assert(WS_WIN + (size_t)2 * WIN_ROWS * DM * 2 == WS_H, "H must follow Win_t");
static_assert(WS_ACT + (size_t)MTOK * DFF * 2 <= WS_END, "ACT fits");
constexpr int CW_TMO = 0, CW_CODE = 1, CW_BAR = 4096, CW_QUEUE = 8192;

constexpr int RING_OFF = 0, RING_BYTES = 131072;
constexpr int XTRA_OFF = RING_BYTES;
constexpr int LDSCTL_OFF = RING_BYTES + 8192, MISC_OFF = LDSCTL_OFF + 320;
constexpr int LDS_BYTES = 147456;
constexpr int NWAVES = 8;

typedef unsigned short bf16;

__device__ __forceinline__ float bf2f(unsigned short b) { return __uint_as_float(((unsigned)b) << 16); }
__device__ __forceinline__ float bflo(unsigned w) { return __uint_as_float(w << 16); }
__device__ __forceinline__ float bfhi(unsigned w) { return __uint_as_float(w & 0xffff0000u); }
__device__ __forceinline__ unsigned pkbf(float lo, float hi) { return pg8::cvt_pk_bf16(lo, hi); }
__device__ __forceinline__ float fast_exp2(float x) { return __builtin_amdgcn_exp2f(x); }
__device__ __forceinline__ float fast_rcp(float x) { return __builtin_amdgcn_rcpf(x); }
__device__ __forceinline__ float gelu_tanh(float x) {
    const float u = 0.7978845608028654f * (x + 0.044715f * x * x * x);
    const float e = fast_exp2(-2.0f * LOG2E * u);
    return x * fast_rcp(1.0f + e);
}
__device__ __forceinline__ float silu_f(float x) { return x * fast_rcp(1.0f + fast_exp2(-LOG2E * x)); }
__device__ __forceinline__ int seq_of_tile(int pm) { return pm < 16 ? 0 : 1 + ((pm - 16) >> 3); }

struct SchedP1 {
    int G, c, pmH;
    __device__ __forceinline__ bool next(int i, pg8::Unit& u) const {
        const int L = i * G + c; if (L >= 800) return false;
        if (L < 640) {
            int wgid = L; { const int q = 640 / 8, xcd = wgid % 8, off = wgid / 8; wgid = xcd * q + off; }
            const int nig = 8 * 8, gid = wgid / nig, fm = gid * 8;
            u.pm = pmH + fm + ((wgid % nig) % 8); u.pn = (wgid % nig) / 8;
        } else { const int Lp = L - 640; u.pm = 8 + (Lp & 1); u.pn = pmH + (Lp >> 1); }
        return true;
    }
    __device__ __forceinline__ void a_ready(const pg8::Unit&) const {}
    __device__ __forceinline__ void done(const pg8::Unit&) const {}
};
struct OneUnit {
    pg8::Unit u0;
    __device__ __forceinline__ bool next(int i, pg8::Unit& u) const { if (i != 0) return false; u = u0; return true; }
    __device__ __forceinline__ void a_ready(const pg8::Unit&) const {}
    __device__ __forceinline__ void done(const pg8::Unit&) const {}
};

typedef unsigned u32x4v __attribute__((ext_vector_type(4)));
typedef unsigned u32x2v __attribute__((ext_vector_type(2)));


struct EpiZ {
    static constexpr bool PERM = true, AFTER_DRAIN = false;
    bf16* Z; bf16* PQL; bf16* PQC; float* newk; float* newv; int layer, pmH;
    __device__ __forceinline__ void operator()(const f32x4 (&acc)[2][2][4][2], const pg8::Unit& u, int wr, int wc, int fr, int fq) const {
        if (u.pm >= pmH) {
            const int tm = u.pm - pmH, pn = u.pn;
            const int row0 = tm * 256 + wr * 64 + fr, col0 = pn * 256 + wc * 32 + 8 * fq;
#pragma unroll
            for (int ai = 0; ai < 2; ++ai)
#pragma unroll
                for (int m = 0; m < 4; ++m) {
                    const int R = row0 + ai * 128 + m * 16;
#pragma unroll
                    for (int bj = 0; bj < 2; ++bj) {
                        const int c = col0 + bj * 128;
                        f32x4 v0 = acc[ai][bj][m][0], v1 = acc[ai][bj][m][1];
                        if (pn >= 4 && tm < 16) {
                            float* dst = (pn < 6 ? newk : newv) + ((size_t)((tm * 2 + layer) * 256 + (R & 255)) * 512 + (c - (pn < 6 ? 1024 : 1536)));
                            *(f32x4*)dst = v0; *(f32x4*)(dst + 4) = v1;
                        }
                        if (pn < 2) {
#pragma unroll
                            for (int j = 0; j < 4; ++j) { v0[j] = gelu_tanh(v0[j]); v1[j] = gelu_tanh(v1[j]); }
                        } else if (pn < 4) { v0 = v0 * QSCALE; v1 = v1 * QSCALE; }
                        u32x4v w; w.x = pkbf(v0[0], v0[1]); w.y = pkbf(v0[2], v0[3]); w.z = pkbf(v1[0], v1[1]); w.w = pkbf(v1[2], v1[3]);
                        *(u32x4v*)(Z + (size_t)R * NZ + c) = w;
                    }
                }
        } else {
            const int pq = u.pm - 8, tn = u.pn - pmH;
            const int nrow0 = wr * 64 + fr, tok0 = tn * 256 + wc * 32 + 8 * fq;
            bf16* base; int ld;
            if (tn < 16) { base = PQC + (size_t)tn * 256 * 512 + pq * 256; ld = 512; }
            else { base = PQL + (size_t)((tn - 16) >> 3) * 256 * 4096 + pq * 2048 + ((tn - 16) & 7) * 256; ld = 4096; }
#pragma unroll
            for (int ai = 0; ai < 2; ++ai)
#pragma unroll
                for (int m = 0; m < 4; ++m) {
                    const int nrow = nrow0 + ai * 128 + m * 16;
#pragma unroll
                    for (int bj = 0; bj < 2; ++bj) {
                        const int t = (tok0 & 255) + bj * 128;
                        const f32x4 v0 = acc[ai][bj][m][0], v1 = acc[ai][bj][m][1];
                        u32x4v w; w.x = pkbf(v0[0], v0[1]); w.y = pkbf(v0[2], v0[3]); w.z = pkbf(v1[0], v1[1]); w.w = pkbf(v1[2], v1[3]);
                        *(u32x4v*)(base + (size_t)nrow * ld + t) = w;
                    }
                }
        }
    }
};

struct EpiRes {
    static constexpr bool PERM = false, AFTER_DRAIN = false;
    const float* xctx; const float* xlat; float* XB; const float* gate;
    __device__ __forceinline__ void operator()(const f32x4 (&acc)[2][2][4][2], const pg8::Unit& u, int wr, int wc, int fr, int fq) const {
        const int row0 = u.pm * 256 + wr * 64 + fr, col0 = u.pn * 256 + wc * 32 + 4 * fq;
        const float* gp = gate + (size_t)seq_of_tile(u.pm) * MODW + col0;
        f32x4 gv[2][2];
#pragma unroll
        for (int bj = 0; bj < 2; ++bj)
#pragma unroll
            for (int n = 0; n < 2; ++n) gv[bj][n] = *(const f32x4*)(gp + bj * 128 + n * 16);
#pragma unroll
        for (int ai = 0; ai < 2; ++ai)
#pragma unroll
            for (int m = 0; m < 4; ++m) {
                const int R = row0 + ai * 128 + m * 16;
                const float* xs = (R < MCTX ? xctx + (size_t)R * DM : xlat + (size_t)(R - MCTX) * DM) + col0;
                float* xo = XB + (size_t)R * DM + col0;
#pragma unroll
                for (int bj = 0; bj < 2; ++bj)
#pragma unroll
                    for (int n = 0; n < 2; ++n) {
                        const f32x4 xv = *(const f32x4*)(xs + bj * 128 + n * 16);
                        *(f32x4*)(xo + bj * 128 + n * 16) = xv * ALPHA_RES + gv[bj][n] * acc[ai][bj][m][n];
                    }
            }
    }
};

struct EpiFourier {
    static constexpr bool PERM = true, AFTER_DRAIN = false;
    bf16* MIX; int rowbase, pnstride;
    __device__ __forceinline__ void operator()(const f32x4 (&acc)[2][2][4][2], const pg8::Unit& u, int wr, int wc, int fr, int fq) const {
        const int row0 = rowbase + u.pn * pnstride + u.pm * 256 + wr * 64 + fr, col0 = 256 + wc * 32 + 8 * fq;
#pragma unroll
        for (int ai = 0; ai < 2; ++ai)
#pragma unroll
            for (int m = 0; m < 4; ++m) {
                bf16* rowp = MIX + (size_t)(row0 + ai * 128 + m * 16) * DM + col0;
#pragma unroll
                for (int bj = 0; bj < 2; ++bj) {
                    const f32x4 v0 = acc[ai][bj][m][0], v1 = acc[ai][bj][m][1];
                    u32x4v w; w.x = pkbf(v0[0], v0[1]); w.y = pkbf(v0[2], v0[3]); w.z = pkbf(v1[0], v1[1]); w.w = pkbf(v1[2], v1[3]);
                    *(u32x4v*)(rowp + bj * 128) = w;
                }
            }
    }
};

struct EpiConv {
    static constexpr bool PERM = true, AFTER_DRAIN = false;
    bf16* ACT; float* EDGE; const float* cw; const float* cb; PG8_LAS float* xl;
    __device__ __forceinline__ void operator()(const f32x4 (&acc)[2][2][4][2], const pg8::Unit& u, int wr, int wc, int fr_, int fq_) const {
        int fr = fr_, fq = fq_; asm volatile("" : "+v"(fr), "+v"(fq));
        const int chl = wc * 32 + 8 * fq, ch0 = u.pn * 128 + chl, lane = fq * 16 + fr;
#pragma unroll
        for (int ai = 0; ai < 2; ++ai) {
            const int blk = ai * 2 + wr;
            if (fr == 0) { *(PG8_LAS f32x4*)(xl + (blk * 2 + 0) * 128 + chl) = acc[ai][0][0][0]; *(PG8_LAS f32x4*)(xl + (blk * 2 + 0) * 128 + chl + 4) = acc[ai][0][0][1]; }
            if (fr == 15) { *(PG8_LAS f32x4*)(xl + (blk * 2 + 1) * 128 + chl) = acc[ai][0][3][0]; *(PG8_LAS f32x4*)(xl + (blk * 2 + 1) * 128 + chl + 4) = acc[ai][0][3][1]; }
        }
        {
            float* eb = EDGE + (size_t)u.pm * 6 * DFF + ch0;
            if (wr == 0 && fr == 0) { *(f32x4*)(eb + 0 * DFF) = acc[0][0][0][0]; *(f32x4*)(eb + 0 * DFF + 4) = acc[0][0][0][1]; *(f32x4*)(eb + 2 * DFF) = acc[0][1][0][0]; *(f32x4*)(eb + 2 * DFF + 4) = acc[0][1][0][1]; }
            if (wr == 0 && fr == 1) { *(f32x4*)(eb + 1 * DFF) = acc[0][0][0][0]; *(f32x4*)(eb + 1 * DFF + 4) = acc[0][0][0][1]; }
            if (wr == 1 && fr == 15) { *(f32x4*)(eb + 3 * DFF) = acc[1][0][3][0]; *(f32x4*)(eb + 3 * DFF + 4) = acc[1][0][3][1]; *(f32x4*)(eb + 5 * DFF) = acc[1][1][3][0]; *(f32x4*)(eb + 5 * DFF + 4) = acc[1][1][3][1]; }
            if (wr == 1 && fr == 14) { *(f32x4*)(eb + 4 * DFF) = acc[1][0][3][0]; *(f32x4*)(eb + 4 * DFF + 4) = acc[1][0][3][1]; }
        }
        asm volatile("s_waitcnt lgkmcnt(0)" ::: "memory"); __builtin_amdgcn_s_barrier(); asm volatile("" ::: "memory");
        f32x4 w0[2], w1[2], w2[2], cbv[2];
#pragma unroll
        for (int n = 0; n < 2; ++n) { w0[n] = *(const f32x4*)(cw + ch0 + 4 * n); w1[n] = *(const f32x4*)(cw + DFF + ch0 + 4 * n); w2[n] = *(const f32x4*)(cw + 2 * DFF + ch0 + 4 * n); cbv[n] = *(const f32x4*)(cb + ch0 + 4 * n); }
        const int lprev = (lane & 48) | ((lane - 1) & 15), lnext = (lane & 48) | ((lane + 1) & 15);
#pragma unroll
        for (int ai = 0; ai < 2; ++ai) {
            const int blk = ai * 2 + wr;
            f32x4 top[2], bot[2];
#pragma unroll
            for (int n = 0; n < 2; ++n) {
                top[n] = blk > 0 ? *(const PG8_LAS f32x4*)(xl + ((blk - 1) * 2 + 1) * 128 + chl + 4 * n) : (f32x4){0.f, 0.f, 0.f, 0.f};
                bot[n] = blk < 3 ? *(const PG8_LAS f32x4*)(xl + ((blk + 1) * 2 + 0) * 128 + chl + 4 * n) : (f32x4){0.f, 0.f, 0.f, 0.f};
            }
#pragma unroll
            for (int n = 0; n < 2; ++n) {
                f32x4 A[4], B[4];
#pragma unroll
                for (int m = 0; m < 4; ++m)
#pragma unroll
                    for (int e = 0; e < 4; ++e) { A[m][e] = __shfl(acc[ai][0][m][n][e], lprev); B[m][e] = __shfl(acc[ai][0][m][n][e], lnext); }
#pragma unroll
                for (int m = 0; m < 4; ++m) {
                    const f32x4 up = (fr != 0) ? A[m] : (m == 0 ? top[n] : A[m == 0 ? 0 : m - 1]);
                    const f32x4 dn = (fr != 15) ? B[m] : (m == 3 ? bot[n] : B[m == 3 ? 3 : m + 1]);
                    const f32x4 gc = cbv[n] + w0[n] * up + w1[n] * acc[ai][0][m][n] + w2[n] * dn;
                    f32x4 o;
#pragma unroll
                    for (int e = 0; e < 4; ++e) o[e] = silu_f(gc[e]) * acc[ai][1][m][n][e];
                    const int R = u.pm * 256 + ai * 128 + wr * 64 + m * 16 + fr;
                    u32x2v w; w.x = pkbf(o[0], o[1]); w.y = pkbf(o[2], o[3]);
                    *(u32x2v*)(ACT + (size_t)R * DFF + ch0 + 4 * n) = w;
                }
            }
        }
    }
};

struct Args {
    const float* in[22];
    float* out; unsigned char* ws;
    int ph_lo, ph_hi;
};
enum { I_XP = 0, I_XS, I_CK, I_CV, I_C, I_CCTX, I_WADA, I_BADA, I_WIN, I_AWS, I_ABS, I_FW, I_RPB, I_WOUT, I_LN1G, I_LN1B, I_WGU, I_CONVW, I_CONVB, I_WDOWN, I_LN2G, I_LN2B };
constexpr int NPHASE = 18;

__device__ __forceinline__ float wave_sum(float v) {
#pragma unroll
    for (int o = 1; o < 64; o <<= 1) v += __shfl_xor(v, o);
    return v;
}
typedef unsigned v4u __attribute__((ext_vector_type(4)));

__device__ __forceinline__ void transpose_item(const float* W, int ldw, bf16* WT, int dst_ld, int k0, int n0, int dstrow0, LAS float* scr, int lane) {
#pragma unroll 8
    for (int i = 0; i < 32; ++i) { const int kk = 2 * i + (lane >> 5); scr[kk * 33 + (lane & 31)] = W[(size_t)(k0 + kk) * ldw + n0 + (lane & 31)]; }
    LDS_WAIT(); asm volatile("" ::: "memory");
    const int c = lane & 7;
#pragma unroll
    for (int j = 0; j < 4; ++j) { const int n = (lane >> 3) + 8 * j; const LAS float* s = scr + (8 * c) * 33 + n;
        v4u o; o.x = pk2(s[0 * 33], s[1 * 33]); o.y = pk2(s[2 * 33], s[3 * 33]); o.z = pk2(s[4 * 33], s[5 * 33]); o.w = pk2(s[6 * 33], s[7 * 33]);
        *(GAS v4u*)(WT + (size_t)(dstrow0 + n) * dst_ld + k0 + 8 * c) = o; }
    LDS_WAIT(); asm volatile("" ::: "memory");
}

__device__ __forceinline__ void ln_row(const float* src, float* xdst, const float* g, const float* bb, bf16* hdst, const float* shift, const float* scale, int lane) {
    f32x4 v[4];
#pragma unroll
    for (int j = 0; j < 4; ++j) v[j] = *((const f32x4*)src + lane + 64 * j);
    if (xdst) {
        float s = 0.f;
#pragma unroll
        for (int j = 0; j < 4; ++j) s += (v[j][0] + v[j][1]) + (v[j][2] + v[j][3]);
        const float mean = wave_sum(s) * (1.f / DM); float s2 = 0.f;
#pragma unroll
        for (int j = 0; j < 4; ++j) { v[j] = v[j] - mean; s2 += (v[j][0] * v[j][0] + v[j][1] * v[j][1]) + (v[j][2] * v[j][2] + v[j][3] * v[j][3]); }
        const float rstd = 1.f / sqrtf(wave_sum(s2) * (1.f / DM) + LN_EPS);
#pragma unroll
        for (int j = 0; j < 4; ++j) { const f32x4 gg = *((const f32x4*)g + lane + 64 * j), bv = *((const f32x4*)bb + lane + 64 * j); v[j] = v[j] * rstd * gg + bv; *((f32x4*)xdst + lane + 64 * j) = v[j]; }
    }
    if (hdst) {
        float s = 0.f;
#pragma unroll
        for (int j = 0; j < 4; ++j) s += (v[j][0] + v[j][1]) + (v[j][2] + v[j][3]);
        const float mean = wave_sum(s) * (1.f / DM); float s2 = 0.f;
#pragma unroll
        for (int j = 0; j < 4; ++j) { v[j] = v[j] - mean; s2 += (v[j][0] * v[j][0] + v[j][1] * v[j][1]) + (v[j][2] * v[j][2] + v[j][3] * v[j][3]); }
        const float rstd = 1.f / sqrtf(wave_sum(s2) * (1.f / DM) + LN_EPS);
#pragma unroll
        for (int j = 0; j < 4; ++j) { const f32x4 sc = *((const f32x4*)scale + lane + 64 * j), sh = *((const f32x4*)shift + lane + 64 * j);
            const f32x4 h = v[j] * rstd * (sc + 1.0f) + sh; u32x2v w; w.x = pkbf(h[0], h[1]); w.y = pkbf(h[2], h[3]);
            *((u32x2v*)hdst + lane + 64 * j) = w; }
    }
}

typedef short bf16x8v __attribute__((ext_vector_type(8)));
typedef float f32x16 __attribute__((ext_vector_type(16)));
constexpr int AT_KS = 0, AT_VT = 9216, AT_RPB = 18432;
__device__ __forceinline__ int crow(int r, int hh) { return (r & 3) + 8 * (r >> 2) + 4 * hh; }

template <bool LAT>
__device__ __forceinline__ void attn_unit(LAS unsigned char* lds, const bf16* Z, const float* ck, const float* cv, const float* rpb, bf16* MIX, int b, int h, int R4, int tid) {
    const int lane = tid & 63, w = __builtin_amdgcn_readfirstlane(tid >> 6), r32 = lane & 31, hh = lane >> 5;
    LAS bf16* KS = (LAS bf16*)(lds + AT_KS); LAS bf16* VT = (LAS bf16*)(lds + AT_VT); LAS float* RPBL = (LAS float*)(lds + AT_RPB);
    int qrow = 0, qcol = 0; size_t Rq;
    if (LAT) { qrow = 4 * R4 + (w >> 1); qcol = 32 * (w & 1) + r32; Rq = (size_t)MCTX + (size_t)b * 2048 + qrow * 64 + qcol; }
    else Rq = (size_t)b * 256 + w * 32 + r32;
    __syncthreads();
    if (LAT) { for (int i = tid; i < 465; i += 512) RPBL[i] = rpb[h * 465 + i] * LOG2E; }
    bf16x8v qf[4];
#pragma unroll
    for (int d0 = 0; d0 < 4; ++d0) qf[d0] = *(const bf16x8v*)(Z + Rq * NZ + 512 + 64 * h + 16 * d0 + 8 * hh);
    int kr_lo = 0, nloc = 0, rsw = 0;
    if (LAT) { const int r0 = 4 * R4; kr_lo = min(max(r0 - 4, 0), 24); const int kr_hi = min(max(r0 + 3 - 4, 0), 24) + 7; nloc = kr_hi - kr_lo + 1; rsw = min(max(qrow - 4, 0), 24); }
    const int NT = LAT ? 8 + nloc : 4;
    const int lkey = tid >> 3, lch = tid & 7;
    const int vpos = (lkey & ~15) | (8 * ((lkey >> 2) & 1) + 4 * ((lkey >> 3) & 1) + (lkey & 3));
    u32x4v kreg, vreg;
#define LOAD_TILE(t_) do { const int t__ = (t_); \
        if (LAT && t__ < 8) { \
            const size_t off = ((size_t)(b * 2) * 512 + (size_t)(64 * t__ + lkey)) * 512 + 64 * h + 8 * lch;     \
            const f32x4 a0 = *(const f32x4*)(ck + off), a1 = *(const f32x4*)(ck + off + 4), c0 = *(const f32x4*)(cv + off), c1 = *(const f32x4*)(cv + off + 4); \
            kreg.x = pkbf(a0[0], a0[1]); kreg.y = pkbf(a0[2], a0[3]); kreg.z = pkbf(a1[0], a1[1]); kreg.w = pkbf(a1[2], a1[3]); \
            vreg.x = pkbf(c0[0], c0[1]); vreg.y = pkbf(c0[2], c0[3]); vreg.z = pkbf(c1[0], c1[1]); vreg.w = pkbf(c1[2], c1[3]); \
        } else { \
            const size_t Rk = LAT ? (size_t)MCTX + (size_t)b * 2048 + (size_t)(kr_lo + (t__ - 8)) * 64 + lkey : (size_t)b * 256 + 64 * t__ + lkey; \
            kreg = *(const u32x4v*)(Z + Rk * NZ + 1024 + 64 * h + 8 * lch); \
            vreg = *(const u32x4v*)(Z + Rk * NZ + 1536 + 64 * h + 8 * lch); \
        } } while (0)
    float mrun = -INFINITY, lrun = 0.f;
    f32x16 o0, o1;
#pragma unroll
    for (int r = 0; r < 16; ++r) { o0[r] = 0.f; o1[r] = 0.f; }
    LOAD_TILE(0);
    for (int t = 0; t < NT; ++t) {
        __syncthreads();
        *(LAS u32x4v*)(KS + lkey * 72 + 8 * lch) = kreg;
        {
            LAS bf16* vp = VT + (8 * lch) * 72 + vpos;
            vp[0 * 72] = (bf16)(vreg.x & 0xffff); vp[1 * 72] = (bf16)(vreg.x >> 16); vp[2 * 72] = (bf16)(vreg.y & 0xffff); vp[3 * 72] = (bf16)(vreg.y >> 16);
            vp[4 * 72] = (bf16)(vreg.z & 0xffff); vp[5 * 72] = (bf16)(vreg.z >> 16); vp[6 * 72] = (bf16)(vreg.w & 0xffff); vp[7 * 72] = (bf16)(vreg.w >> 16);
        }
        __syncthreads();
        if (t + 1 < NT) LOAD_TILE(t + 1);
        const bool local = LAT && t >= 8;
        const int kr = kr_lo + (t - 8);
        if (local && (kr < rsw || kr > rsw + 7)) continue;
        f32x16 p0, p1;
#pragma unroll
        for (int r = 0; r < 16; ++r) { p0[r] = 0.f; p1[r] = 0.f; }
#pragma unroll
        for (int d0 = 0; d0 < 4; ++d0) {
            const bf16x8v k0 = *(const LAS bf16x8v*)(KS + r32 * 72 + 16 * d0 + 8 * hh);
            const bf16x8v k1 = *(const LAS bf16x8v*)(KS + (32 + r32) * 72 + 16 * d0 + 8 * hh);
            p0 = __builtin_amdgcn_mfma_f32_32x32x16_bf16(k0, qf[d0], p0, 0, 0, 0);
            p1 = __builtin_amdgcn_mfma_f32_32x32x16_bf16(k1, qf[d0], p1, 0, 0, 0);
        }
        if (local) {
            const int cs = min(max(qcol - 8, 0), 48);
            const int rbase = (kr - qrow + 7) * 31 + 15 - qcol;
#pragma unroll
            for (int r = 0; r < 16; ++r) {
                const int kc0 = crow(r, hh), kc1 = kc0 + 32;
                const bool v0 = (unsigned)(kc0 - cs) < 16u, v1 = (unsigned)(kc1 - cs) < 16u;
                const float b0 = RPBL[v0 ? rbase + kc0 : 0], b1 = RPBL[v1 ? rbase + kc1 : 0];
                p0[r] = v0 ? p0[r] + b0 : -INFINITY; p1[r] = v1 ? p1[r] + b1 : -INFINITY;
            }
        }
        float tmax = fmaxf(p0[0], p1[0]);
#pragma unroll
        for (int r = 1; r < 16; ++r) tmax = fmaxf(tmax, fmaxf(p0[r], p1[r]));
        tmax = fmaxf(tmax, __shfl_xor(tmax, 32));
        const float mnew = fmaxf(mrun, tmax);
        const float alpha = fast_exp2(mrun - mnew);
        mrun = mnew;
        float ls = 0.f;
#pragma unroll
        for (int r = 0; r < 16; ++r) { p0[r] = fast_exp2(p0[r] - mnew); p1[r] = fast_exp2(p1[r] - mnew); ls += p0[r] + p1[r]; }
        lrun = lrun * alpha + ls;
#pragma unroll
        for (int r = 0; r < 16; ++r) { o0[r] *= alpha; o1[r] *= alpha; }
        bf16x8v pb[4];
#pragma unroll
        for (int s = 0; s < 2; ++s) {
            u32x4v a, c;
            a.x = pkbf(p0[8 * s + 0], p0[8 * s + 1]); a.y = pkbf(p0[8 * s + 2], p0[8 * s + 3]); a.z = pkbf(p0[8 * s + 4], p0[8 * s + 5]); a.w = pkbf(p0[8 * s + 6], p0[8 * s + 7]);
            c.x = pkbf(p1[8 * s + 0], p1[8 * s + 1]); c.y = pkbf(p1[8 * s + 2], p1[8 * s + 3]); c.z = pkbf(p1[8 * s + 4], p1[8 * s + 5]); c.w = pkbf(p1[8 * s + 6], p1[8 * s + 7]);
            pb[s] = __builtin_bit_cast(bf16x8v, a); pb[2 + s] = __builtin_bit_cast(bf16x8v, c);
        }
#pragma unroll
        for (int ks = 0; ks < 4; ++ks) {
            const bf16x8v va = *(const LAS bf16x8v*)(VT + r32 * 72 + 16 * ks + 8 * hh);
            const bf16x8v vb = *(const LAS bf16x8v*)(VT + (32 + r32) * 72 + 16 * ks + 8 * hh);
            o0 = __builtin_amdgcn_mfma_f32_32x32x16_bf16(va, pb[ks], o0, 0, 0, 0);
            o1 = __builtin_amdgcn_mfma_f32_32x32x16_bf16(vb, pb[ks], o1, 0, 0, 0);
        }
    }
    lrun += __shfl_xor(lrun, 32);
    const float inv = 1.0f / lrun;
    bf16* op = MIX + Rq * DM + 512 + 64 * h + 4 * hh;
#pragma unroll
    for (int g4 = 0; g4 < 4; ++g4) {
        u32x2v a, c;
        a.x = pkbf(o0[4 * g4 + 0] * inv, o0[4 * g4 + 1] * inv); a.y = pkbf(o0[4 * g4 + 2] * inv, o0[4 * g4 + 3] * inv);
        c.x = pkbf(o1[4 * g4 + 0] * inv, o1[4 * g4 + 1] * inv); c.y = pkbf(o1[4 * g4 + 2] * inv, o1[4 * g4 + 3] * inv);
        *(u32x2v*)(op + 8 * g4) = a; *(u32x2v*)(op + 32 + 8 * g4) = c;
    }
}

#undef LOAD_TILE
constexpr int GM_PITCH = 136;
__device__ __forceinline__ void gmlp_unit(LAS unsigned char* lds, const bf16* Z, const bf16* AWS  , const float* abs_  , bf16* MIX, int cidx, int tid) {
    const int lane = tid & 63, w = __builtin_amdgcn_readfirstlane(tid >> 6), r32 = lane & 31, hh = lane >> 5;
    LAS bf16* VT = (LAS bf16*)lds;
    const size_t R0 = (size_t)cidx * 128;
    __syncthreads();
    for (int i = 0; i < 16; ++i) {
        const int q = w * 16 + i;
        const u32x2v raw = *(const u32x2v*)(Z + (R0 + q) * NZ + 256 + 4 * lane);
        float x0 = bflo(raw.x), x1 = bfhi(raw.x), x2 = bflo(raw.y), x3 = bfhi(raw.y);
        const float mean = wave_sum((x0 + x1) + (x2 + x3)) * (1.f / 256.f);
        x0 -= mean; x1 -= mean; x2 -= mean; x3 -= mean;
        const float rstd = 1.f / sqrtf(wave_sum((x0 * x0 + x1 * x1) + (x2 * x2 + x3 * x3)) * (1.f / 256.f) + LN_EPS);
        const unsigned a = pkbf(x0 * rstd, x1 * rstd), c = pkbf(x2 * rstd, x3 * rstd);
        LAS bf16* vp = VT + (4 * lane) * GM_PITCH + q;
        vp[0] = (bf16)(a & 0xffff); vp[GM_PITCH] = (bf16)(a >> 16); vp[2 * GM_PITCH] = (bf16)(c & 0xffff); vp[3 * GM_PITCH] = (bf16)(c >> 16);
    }
    __syncthreads();
    const int h = w >> 1, chb = 64 * h + 32 * (w & 1);
    f32x16 acc[4];
#pragma unroll
    for (int nt = 0; nt < 4; ++nt)
#pragma unroll
        for (int r = 0; r < 16; ++r) acc[nt][r] = 0.f;
#pragma unroll
    for (int ks = 0; ks < 8; ++ks) {
        const bf16x8v a = *(const LAS bf16x8v*)(VT + (chb + r32) * GM_PITCH + 16 * ks + 8 * hh);
#pragma unroll
        for (int nt = 0; nt < 4; ++nt) {
            const bf16x8v bq = *(const bf16x8v*)(AWS + (size_t)(h * 128 + 32 * nt + r32) * 128 + 16 * ks + 8 * hh);
            acc[nt] = __builtin_amdgcn_mfma_f32_32x32x16_bf16(a, bq, acc[nt], 0, 0, 0);
        }
    }
#pragma unroll
    for (int nt = 0; nt < 4; ++nt) {
        const int p = 32 * nt + r32;
        const float bsv = abs_[h * 128 + p];
#pragma unroll
        for (int g4 = 0; g4 < 4; ++g4) {
            const int ch = chb + 8 * g4 + 4 * hh;
            const u32x2v uu = *(const u32x2v*)(Z + (R0 + p) * NZ + ch);
            u32x2v o;
            o.x = pkbf(bflo(uu.x) * (acc[nt][4 * g4 + 0] + bsv), bfhi(uu.x) * (acc[nt][4 * g4 + 1] + bsv));
            o.y = pkbf(bflo(uu.y) * (acc[nt][4 * g4 + 2] + bsv), bfhi(uu.y) * (acc[nt][4 * g4 + 3] + bsv));
            *(u32x2v*)(MIX + (R0 + p) * DM + ch) = o;
        }
    }
}

typedef const __attribute__((address_space(4))) Args* ArgsP;
__device__ __forceinline__ void phase_prologue(ArgsP ap, LAS unsigned char* lds, int tid, int G, int vcu) {
    const int lane = tid & 63, wave = __builtin_amdgcn_readfirstlane(tid >> 6);
    unsigned char* ws = ap->ws;
    LAS float* COS = (LAS float*)(lds + XTRA_OFF);
    for (int j = tid; j < 2048; j += 512) COS[j] = cospif((float)j * (1.0f / 1024.0f));
    __syncthreads();
    if (vcu < 32) {
        const int lyr = vcu >> 4, g = (vcu >> 2) & 3, qk = vcu & 3;
        LAS float* FW = (LAS float*)(lds);
        LAS float* WCt = (LAS float*)(lds + 16384);
        LAS float* WSt = (LAS float*)(lds + 16384 + 64 * 68 * 4);
        const float* fw = ap->in[I_FW] + (size_t)(lyr * 4 + g) * 4096;
        for (int i = tid; i < 4096; i += 512) FW[i] = fw[i];
        __syncthreads();
        {
            const int d = tid & 63, c0 = (tid >> 6) * 8;
#pragma unroll 1
            for (int cc = 0; cc < 8; ++cc) {
                const int c = c0 + cc; float sc = 0.f, ss = 0.f;
                for (int m = 0; m < 64; ++m) { const int j = (m * c) & 63; const float f = FW[m * 64 + d]; sc += COS[32 * j] * f; ss += COS[32 * ((j + 48) & 63)] * f; }
                WCt[d * 68 + c] = sc * 0.125f; WSt[d * 68 + c] = ss * 0.125f;
            }
        }
        __syncthreads();
        {
            const int pq = wave & 1, ksub = wave >> 1;
            const int k = 256 * qk + 64 * ksub + lane;
            const float* wrow = ap->in[I_WIN] + (size_t)lyr * DM * PIN + (size_t)k * PIN + 512 + 64 * g;
            f32x4 wv[16];
#pragma unroll
            for (int i = 0; i < 16; ++i) wv[i] = *(const f32x4*)(wrow + 4 * i);
            const LAS float* Wt = pq ? WSt : WCt;
            bf16* dst = (bf16*)(ws + WS_WIN) + (size_t)lyr * WIN_ROWS * DM + (size_t)(2048 + pq * 256 + g * 64) * DM + k;
#pragma unroll 2
            for (int d = 0; d < 64; ++d) {
                float s = 0.f;
#pragma unroll
                for (int i = 0; i < 16; ++i) { const f32x4 t = *(const LAS f32x4*)(Wt + d * 68 + 4 * i); s += (wv[i][0] * t[0] + wv[i][1] * t[1]) + (wv[i][2] * t[2] + wv[i][3] * t[3]); }
                dst[(size_t)d * DM] = (bf16)f2bf(s);
            }
        }
        __syncthreads();
    }
    LAS float* scr = (LAS float*)(lds + RING_OFF + wave * 16384);
    const int gw = vcu * NWAVES + wave, NGW = G * NWAVES;
    constexpr int N_MOD = 192, N_TR = 11520, N_DFT = 2048, N_DFTC = 256, N_AWS = 256;
    constexpr int NITEMS = N_MOD + N_TR + N_DFT + N_DFTC + N_AWS;
    for (int it = gw; it < NITEMS; it += NGW) {
        asm volatile("" : "+s"(ap));
        ws = ap->ws;
        int r = it;
        if (r < N_MOD) {
            const int lyr = r / 96, n = 64 * (r % 96) + lane;
            const float* wa = ap->in[I_WADA] + (size_t)lyr * DM * MODW + n;
            float acc[9];
#pragma unroll
            for (int s = 0; s < 9; ++s) acc[s] = 0.f;
            for (int kc = 0; kc < 16; ++kc) {
                float sil[9];
                sil[0] = silu_f(ap->in[I_CCTX][64 * kc + lane]);
#pragma unroll
                for (int s = 1; s < 9; ++s) sil[s] = silu_f(ap->in[I_C][(s - 1) * DM + 64 * kc + lane]);
#pragma unroll 16
                for (int kk = 0; kk < 64; ++kk) {
                    const float wv = wa[(size_t)(64 * kc + kk) * MODW];
#pragma unroll
                    for (int s = 0; s < 9; ++s) acc[s] += __int_as_float(__builtin_amdgcn_readlane(__float_as_int(sil[s]), kk)) * wv;
                }
            }
            const float bias = ap->in[I_BADA][lyr * MODW + n];
            float* mo = (float*)(ws + WS_MOD) + (size_t)lyr * 9 * MODW + n;
#pragma unroll
            for (int s = 0; s < 9; ++s) mo[(size_t)s * MODW] = acc[s] + bias;
            continue;
        }
        r -= N_MOD;
        if (r < N_TR) {
            const int lyr = r / 5760; r %= 5760;
            if (r < 1024) { const int nb = r % 64, kb = r / 64, dc = 32 * nb, sc = dc < 512 ? dc : dc + 256;
                transpose_item(ap->in[I_WIN] + (size_t)lyr * DM * PIN, PIN, (bf16*)(ws + WS_WIN) + (size_t)lyr * WIN_ROWS * DM, DM, 64 * kb, sc, dc, scr, lane); continue; }
            r -= 1024;
            if (r < 512) { const int nb = r % 32, kb = r / 32;
                transpose_item(ap->in[I_WOUT] + (size_t)lyr * DM * DM, DM, (bf16*)(ws + WS_WOUT) + (size_t)lyr * DM * DM, DM, 64 * kb, 32 * nb, 32 * nb, scr, lane); continue; }
            r -= 512;
            if (r < 2816) { const int nb = r % 176, kb = r / 176, sc = 32 * nb, ch = sc < DFF ? sc : sc - DFF, dr = 256 * (ch >> 7) + (ch & 127) + (sc < DFF ? 0 : 128);
                transpose_item(ap->in[I_WGU] + (size_t)lyr * DM * NGU, NGU, (bf16*)(ws + WS_WGU) + (size_t)lyr * NGU * DM, DM, 64 * kb, sc, dr, scr, lane); continue; }
            r -= 2816;
            { const int nb = r % 32, kb = r / 32;
                transpose_item(ap->in[I_WDOWN] + (size_t)lyr * DFF * DM, DM, (bf16*)(ws + WS_WDN) + (size_t)lyr * DM * DFF, DFF, 64 * kb, 32 * nb, 32 * nb, scr, lane); continue; }
        }
        r -= N_TR;
        if (r < N_DFT) {
            const int k = r; bf16* row = (bf16*)(ws + WS_DFT) + (size_t)k * 4096;
            const float sc = 0.02209708691207961f;
#pragma unroll 1
            for (int st = 0; st < 4; ++st) {
                const int l0 = 8 * (lane + 64 * st); float c[8], s[8];
#pragma unroll
                for (int e = 0; e < 8; ++e) { const int idx = (k * (l0 + e)) & 2047; c[e] = COS[idx] * sc; s[e] = -COS[(idx + 1536) & 2047] * sc; }
                v4u oc, os; oc.x = pk2(c[0], c[1]); oc.y = pk2(c[2], c[3]); oc.z = pk2(c[4], c[5]); oc.w = pk2(c[6], c[7]);
                os.x = pk2(s[0], s[1]); os.y = pk2(s[2], s[3]); os.z = pk2(s[4], s[5]); os.w = pk2(s[6], s[7]);
                *(v4u*)(row + l0) = oc; *(v4u*)(row + 2048 + l0) = os;
            }
            continue;
        }
        r -= N_DFT;
        if (r < N_DFTC) {
            const int k = r; bf16* row = (bf16*)(ws + WS_DFT256) + (size_t)k * 512;
            const int l0 = 8 * (lane & 31); const bool sn = lane >= 32; float v[8];
#pragma unroll
            for (int e = 0; e < 8; ++e) { const int idx = (k * (l0 + e) * 8) & 2047; v[e] = sn ? -COS[(idx + 1536) & 2047] * 0.0625f : COS[idx] * 0.0625f; }
            v4u o; o.x = pk2(v[0], v[1]); o.y = pk2(v[2], v[3]); o.z = pk2(v[4], v[5]); o.w = pk2(v[6], v[7]);
            *(v4u*)(row + (sn ? 256 : 0) + l0) = o;
            continue;
        }
        r -= N_DFTC;
        {
            const size_t i0 = (size_t)r * 512 + lane * 8;
            const f32x4 x0 = *(const f32x4*)(ap->in[I_AWS] + i0), x1 = *(const f32x4*)(ap->in[I_AWS] + i0 + 4);
            v4u o; o.x = pk2(x0[0], x0[1]); o.y = pk2(x0[2], x0[3]); o.z = pk2(x1[0], x1[1]); o.w = pk2(x1[2], x1[3]);
            *(v4u*)((bf16*)(ws + WS_AWS) + i0) = o;
        }
    }
}

__global__ void __launch_bounds__(NWAVES * 64, 2) mega_fwd(Args args) {
    extern __shared__ __attribute__((aligned(16))) unsigned char lds_raw[];
    LAS unsigned char* lds = (LAS unsigned char*)lds_raw;
    volatile LAS unsigned* MISC = (volatile LAS unsigned*)(lds + MISC_OFF);
    const int tid0 = threadIdx.x;
    const int G0 = gridDim.x, bx0 = blockIdx.x;
    ArgsP ap = (ArgsP)__builtin_amdgcn_kernarg_segment_ptr();
    unsigned char* ws = ap->ws;
    gu32* ctl = (gu32*)(ws + WS_CTL);
    for (int u = tid0; u < (LDS_BYTES - LDSCTL_OFF) / 4; u += NWAVES * 64) ((LAS unsigned*)(lds + LDSCTL_OFF))[u] = 0u;
    __syncthreads();
    const int ph_lo = ap->ph_lo, ph_hi = ap->ph_hi;
    const bool multi = (ph_hi - ph_lo) > 1;
    XcdBarrier bar; bar.bar = (unsigned*)(ctl + CW_BAR); bar.x = 0; bar.st = nullptr;
    if (multi) bar = xcd_barrier_post((unsigned*)(ctl + CW_BAR), MISC + 8);


    for (int ph = ph_lo; ph < ph_hi; ++ph) {
        asm volatile("" : "+s"(ap));
        int tid = tid0, G = G0, bx = bx0;
        asm volatile("" : "+v"(tid)); asm volatile("" : "+s"(G)); asm volatile("" : "+s"(bx));
        const int lane = tid & 63, wave = __builtin_amdgcn_readfirstlane(tid >> 6);
        const int vcu = (G % 8 == 0) ? (bx % 8) * (G / 8) + bx / 8 : bx;
        const int gw = vcu * NWAVES + wave, NGW = G * NWAVES;
        ws = ap->ws;
        bf16* const H = (bf16*)(ws + WS_H); bf16* const Zb = (bf16*)(ws + WS_Z); bf16* const MIX = (bf16*)(ws + WS_MIX); bf16* const ACT = (bf16*)(ws + WS_ACT);
        float* const MOD = (float*)(ws + WS_MOD); float* const XB = ap->out; float* const EDGE = (float*)(ws + WS_EDGE);
        ctl = (gu32*)(ws + WS_CTL);
        if (ph == 0) {
#ifndef NO_P0
            phase_prologue(ap, lds, tid, G, vcu);
#endif
        } else if (ph == 1) {
            for (int m = gw; m < MTOK; m += NGW) {
                const float* src = m < MCTX ? ap->in[I_XP] + (size_t)m * DM : ap->in[I_XS] + (size_t)(m - MCTX) * DM;
                const float* modp = MOD + (size_t)(m < MCTX ? 0 : 1 + ((m - MCTX) >> 11)) * MODW;
                ln_row(src, nullptr, nullptr, nullptr, H + (size_t)m * DM, modp, modp + 1024, lane);
            }
        } else {
            const int l = (ph - 2) >> 3, sub = (ph - 2) & 7;
            const float* modl = MOD + (size_t)l * 9 * MODW;
            if (sub == 0) {
                const bf16* base = (const bf16*)(ws + WS_WIN) + (size_t)l * WIN_ROWS * DM;
                pg8::Gemm g{base, base, 0, 0, DM};
                SchedP1 S{G, bx, l == 0 ? 20 : 10};
                EpiZ E{Zb, (bf16*)(ws + WS_PQL), (bf16*)(ws + WS_PQC), XB + (size_t)MTOK * DM, XB + (size_t)MTOK * DM + (size_t)16 * 2 * 256 * 512, l, l == 0 ? 20 : 10};
#ifndef NO_G1
                pg8::gemm_phase<EpiZ, SchedP1, PG8_ALIGN, PG8_SP2>(lds + RING_OFF, g, S, E);
#endif
            } else if (sub == 1) {
                for (;;) {
                    asm volatile("" : "+s"(ap));
                    int tidu = tid; asm volatile("" : "+v"(tidu));
                    unsigned char* wsq = ap->ws;
                    __syncthreads();
                    if (tid == 0) MISC[4] = __hip_atomic_fetch_add((gu32*)(wsq + WS_CTL) + CW_QUEUE + 64 * l, 1u, __ATOMIC_RELAXED, __HIP_MEMORY_SCOPE_AGENT);
                    __syncthreads();
                    const int idx = (int)MISC[4];
                    if (idx >= 880) break;
                    if (idx < 64 || (idx >= 576 && idx < 592)) {
                        const bool lat = idx < 64; const int j = lat ? idx : idx - 576;
                        pg8::Gemm g{lat ? (const bf16*)(wsq + WS_DFT) : (const bf16*)(wsq + WS_DFT256), lat ? (const bf16*)(wsq + WS_PQL) : (const bf16*)(wsq + WS_PQC), 0, 0, lat ? 4096 : 512};
                        OneUnit S{{lat ? (j & 7) : 0, lat ? (j >> 3) : j}};
                        EpiFourier E{(bf16*)(wsq + WS_MIX), lat ? MCTX : 0, lat ? 2048 : 256};
#ifndef NO_FO
                        pg8::gemm_phase<EpiFourier, OneUnit, PG8_ALIGN, PG8_SP2>(lds + RING_OFF, g, S, E);
#endif
                    } else if (idx < 576) {
                        const int u = idx - 64;
#ifndef NO_AL
                        attn_unit<true>(lds + RING_OFF, (const bf16*)(wsq + WS_Z), ap->in[I_CK] + (size_t)l * 512 * 512, ap->in[I_CV] + (size_t)l * 512 * 512, ap->in[I_RPB] + (size_t)l * 8 * 465,
                                        (bf16*)(wsq + WS_MIX), u >> 6, (u >> 3) & 7, u & 7, tidu);
#endif
                    } else if (idx < 720) {
                        const int u = idx - 592;
#ifndef NO_AC
                        attn_unit<false>(lds + RING_OFF, (const bf16*)(wsq + WS_Z), nullptr, nullptr, nullptr, (bf16*)(wsq + WS_MIX), u >> 3, u & 7, 0, tidu);
#endif
                    } else {
#ifndef NO_GM
                        gmlp_unit(lds + RING_OFF, (const bf16*)(wsq + WS_Z), (const bf16*)(wsq + WS_AWS) + (size_t)l * 4 * 128 * 128, ap->in[I_ABS] + (size_t)l * 4 * 128, (bf16*)(wsq + WS_MIX), idx - 720, tidu);
#endif
                    }
                }
            } else if (sub == 2 || sub == 6) {
                const bool dn = sub == 6;
                pg8::Gemm g{dn ? (const bf16*)ACT : (const bf16*)MIX, dn ? (const bf16*)(ws + WS_WDN) + (size_t)l * DM * DFF : (const bf16*)(ws + WS_WOUT) + (size_t)l * DM * DM, 0, 0, dn ? DFF : DM};
                pg8::StaticOrder S; S.init(MTOK, DM, G, bx);
                const bool fromin = (!dn && l == 0);
                EpiRes E{fromin ? ap->in[I_XP] : (const float*)XB, fromin ? ap->in[I_XS] : (const float*)(XB + (size_t)MCTX * DM), XB, modl + (dn ? 5120 : 2048)};
#ifndef NO_G2
                pg8::gemm_phase<EpiRes, pg8::StaticOrder, PG8_ALIGN, PG8_SP2>(lds + RING_OFF, g, S, E);
#endif
            } else if (sub == 3 || sub == 7) {
                const bool second = sub == 7;
                const float* gg = ap->in[second ? I_LN2G : I_LN1G] + (size_t)l * DM; const float* bb = ap->in[second ? I_LN2B : I_LN1B] + (size_t)l * DM;
                const bool wanth = !second || l == 0;
                for (int m = gw; m < MTOK; m += NGW) {
                    const int s = m < MCTX ? 0 : 1 + ((m - MCTX) >> 11);
                    const float* modp = second ? MOD + (size_t)(9 + s) * MODW : modl + (size_t)s * MODW + 3072;
                    float* xr = XB + (size_t)m * DM;
                    ln_row(xr, xr, gg, bb, wanth ? H + (size_t)m * DM : nullptr, modp, modp + 1024, lane);
                }
            } else if (sub == 4) {
                pg8::Gemm g{(const bf16*)H, (const bf16*)(ws + WS_WGU) + (size_t)l * NGU * DM, 0, 0, DM};
                pg8::StaticOrder S; S.init(MTOK, NGU, G, bx);
                EpiConv E{ACT, EDGE, ap->in[I_CONVW] + (size_t)l * 3 * DFF, ap->in[I_CONVB] + (size_t)l * DFF, (PG8_LAS float*)(lds + XTRA_OFF)};
#ifndef NO_G3
                pg8::gemm_phase<EpiConv, pg8::StaticOrder, true, PG8_SP2>(lds + RING_OFF, g, S, E);
#endif
            } else {
                const float* cw = ap->in[I_CONVW] + (size_t)l * 3 * DFF; const float* cb = ap->in[I_CONVB] + (size_t)l * DFF;
                for (int it = gw; it < 160; it += NGW) {
                    const int pm = it >> 1, bot = it & 1;
                    const bool first = pm < 16 || ((pm - 16) & 7) == 0, last = pm < 16 || ((pm - 16) & 7) == 7;
                    const float* e = EDGE + (size_t)pm * 6 * DFF;
                    const int R = pm * 256 + (bot ? 255 : 0);
                    for (int ch = lane; ch < DFF; ch += 64) {
                        float gm, g0, gp, uu;
                        if (!bot) { gm = first ? 0.f : e[-(ptrdiff_t)(6 * DFF) + 3 * DFF + ch]; g0 = e[ch]; gp = e[DFF + ch]; uu = e[2 * DFF + ch]; }
                        else { gm = e[4 * DFF + ch]; g0 = e[3 * DFF + ch]; gp = last ? 0.f : e[6 * DFF + ch]; uu = e[5 * DFF + ch]; }
                        const float gc = cb[ch] + cw[ch] * gm + cw[DFF + ch] * g0 + cw[2 * DFF + ch] * gp;
                        ACT[(size_t)R * DFF + ch] = (bf16)f2bf(silu_f(gc) * uu);
                    }
                }
            }
        }
        if (ph + 1 < ph_hi) xcd_barrier(bar);
    }
}

#ifndef MK_PER_PHASE
#define MK_PER_PHASE 0
#endif
extern "C" void kernel_launch(void* const* d_in, const int* in_sizes, int n_in, void* d_out, int out_size, void* d_ws, size_t ws_size, hipStream_t stream) {
    static int grid = 0;
    if (grid == 0) {
        if (n_in != 22 || ws_size < WS_END || out_size != MTOK * DM + 2 * 16 * 2 * 256 * 512) { fprintf(stderr, "kernel_launch: unexpected problem (n_in %d, out %d, ws %zu)\n", n_in, out_size, ws_size); grid = -1; return; }
        int dev = 0, cus = 0;
        if (hipGetDevice(&dev) != hipSuccess || hipDeviceGetAttribute(&cus, hipDeviceAttributeMultiprocessorCount, dev) != hipSuccess) { grid = -1; return; }
        if (hipFuncSetAttribute((const void*)mega_fwd, hipFuncAttributeMaxDynamicSharedMemorySize, LDS_BYTES) != hipSuccess) { fprintf(stderr, "kernel_launch: hipFuncSetAttribute failed\n"); grid = -1; return; }
        (void)hipGetLastError();
        grid = cus;
    }
    if (grid < 0) return;
    (void)hipMemsetAsync((char*)d_ws + WS_CTL, 0, CTL_ZERO_BYTES, stream);
    Args a{};
    for (int i = 0; i < 22; ++i) a.in[i] = (const float*)d_in[i];
    a.out = (float*)d_out; a.ws = (unsigned char*)d_ws;
#if MK_PER_PHASE
    for (int ph = 0; ph < NPHASE; ++ph) { a.ph_lo = ph; a.ph_hi = ph + 1; hipLaunchKernelGGL(mega_fwd, dim3(grid), dim3(NWAVES * 64), LDS_BYTES, stream, a); }
#else
    a.ph_lo = 0; a.ph_hi = NPHASE;
    hipLaunchKernelGGL(mega_fwd, dim3(grid), dim3(NWAVES * 64), LDS_BYTES, stream, a);
#endif
}
```

```cpp
#include <hip/hip_runtime.h>
#include <cstdio>
#include <cstdint>
namespace pg8 {
#define PG8_LAS __attribute__((address_space(3)))
typedef unsigned short bf16_t;
typedef short bf16x8 __attribute__((ext_vector_type(8)));
typedef float f32x4 __attribute__((ext_vector_type(4)));
typedef unsigned u32x4 __attribute__((ext_vector_type(4)));
constexpr int BM = 256, BK = 64, HALF = 128, HTB = HALF * BK * 2  , STAGE_BYTES = 8 * HTB, NXCD = 8, WGM = 8;

__host__ __device__ __forceinline__ int lds_byte(int r, int c) { const int st = (r >> 4) * 2 + (c >> 5), rr = r & 15, cc = c & 31, ob = rr * 64 + cc * 2; return st * 1024 + (ob ^ (((ob >> 9) & 1) << 5)); }
__host__ __device__ __forceinline__ void stage_rc(int b, int& R, int& C) { const int st = b / 1024, sb = b % 1024, swz = sb ^ (((sb >> 9) & 1) << 5); R = (st >> 1) * 16 + swz / 64; C = (st & 1) * 32 + (swz % 64) / 2; }
__host__ __device__ __forceinline__ int perm32(int rho) { const int n = rho >> 4, i = rho & 15; return 8 * (i >> 2) + 4 * n + (i & 3); }

struct Unit { int pm, pn; };
struct Gemm { const bf16_t* A; const bf16_t* Bt; int M, N, K; };

struct StaticOrder {
    int nM, nN, nwg, G, c;
    __host__ __device__ void init(int M, int N, int G_, int c_) { nM = M / BM; nN = N / BM; nwg = nM * nN; G = G_; c = c_; }
    __host__ __device__ bool next(int i, Unit& u) const {
        const long L = (long)i * G + c; if (L >= nwg) return false;
        int wgid = (int)L; { const int q = nwg / NXCD, r = nwg % NXCD, xcd = wgid % NXCD, off = wgid / NXCD; wgid = (xcd < r ? xcd * (q + 1) : r * (q + 1) + (xcd - r) * q) + off; }
        const int nig = WGM * nN, gid = wgid / nig, fm = gid * WGM, gsz = (nM - fm) < WGM ? (nM - fm) : WGM;
        u.pm = fm + ((wgid % nig) % gsz); u.pn = (wgid % nig) / gsz; return true;
    }
    __device__ __forceinline__ void a_ready(const Unit&) const {}
    __device__ __forceinline__ void done(const Unit&) const {}
};
__device__ __forceinline__ unsigned cvt_pk_bf16(float lo, float hi) { unsigned r; asm volatile("v_cvt_pk_bf16_f32 %0, %1, %2" : "=v"(r) : "v"(lo), "v"(hi)); return r; }
template <class Epi, class Sched, bool ALIGN_EPI = false, bool SP2 = false>
__device__ __forceinline__ void gemm_phase(PG8_LAS unsigned char* lds, const Gemm g, const Sched& S, const Epi& E) {
    int tid = threadIdx.x; asm volatile("" : "+v"(tid));
    const int wid = __builtin_amdgcn_readfirstlane(tid >> 6), lane = tid & 63, wr = wid >> 2, wc = wid & 3, fr = lane & 15, fq = lane >> 4;
    const int K = g.K, nt = K / BK;
    unsigned voffA[2], voffB[2];
#pragma unroll
    for (int i = 0; i < 2; ++i) { int R, C; stage_rc(tid * 16 + i * 8192, R, C); const int Rb = Epi::PERM ? ((R & ~31) + perm32(R & 31)) : R;
        voffA[i] = (unsigned)(R * K + C) * 2u; voffB[i] = (unsigned)(Rb * K + C) * 2u; }
    const size_t kstep = (size_t)(BK * 2);
    const size_t hstep = (size_t)HALF * K * 2;
    const size_t tstep = 2 * hstep;
    const unsigned ldsw = (unsigned)wid * 1024u;
    const int aoff = lds_byte(wr * 64 + fr, fq * 8), boff = lds_byte(wc * 32 + fr, fq * 8);
#define PG8_SA(b, h) (((b) * 2 + (h)) * HTB)
#define PG8_SB(b, h) ((4 + (b) * 2 + (h)) * HTB)
#define PG8_STAGE(bufoff, gbase, voff) do { _Pragma("unroll") for (int _i = 0; _i < 2; ++_i) \
        __builtin_amdgcn_global_load_lds((const unsigned*)((const char*)(gbase) + (voff)[_i]), (PG8_LAS unsigned*)(lds + (bufoff) + ldsw + _i * 8192), 16, 0, 0); } while (0)
#define PG8_LDA(dst, b, h) do { _Pragma("unroll") for (int m = 0; m < 4; ++m) _Pragma("unroll") for (int k = 0; k < 2; ++k) dst[m][k] = *(const PG8_LAS bf16x8*)(lds + PG8_SA(b, h) + aoff + m * 2048 + k * 1024); } while (0)
#define PG8_LDB(dst, b, h) do { _Pragma("unroll") for (int n = 0; n < 2; ++n) _Pragma("unroll") for (int k = 0; k < 2; ++k) dst[n][k] = *(const PG8_LAS bf16x8*)(lds + PG8_SB(b, h) + boff + n * 2048 + k * 1024); } while (0)
#define PG8_MMA(ai, bj, At, Bt) do { __builtin_amdgcn_s_setprio(1); _Pragma("unroll") for (int m = 0; m < 4; ++m) _Pragma("unroll") for (int n = 0; n < 2; ++n) _Pragma("unroll") for (int k = 0; k < 2; ++k) \
        acc[ai][bj][m][n] = __builtin_amdgcn_mfma_f32_16x16x32_bf16(Bt[n][k], At[m][k], acc[ai][bj][m][n], 0, 0, 0); __builtin_amdgcn_s_setprio(0); } while (0)
#define PG8_WAIT_V(n) asm volatile("s_waitcnt vmcnt(" #n ")" ::: "memory")
#define PG8_WAIT_L(n) asm volatile("s_waitcnt lgkmcnt(" #n ")" ::: "memory")
#define PG8_BAR __builtin_amdgcn_s_barrier()
#define PG8_SCHED __builtin_amdgcn_sched_barrier(0)
    Unit cur, nxt; int ui = 0;
    if (!S.next(0, cur)) return;
    f32x4 acc[2][2][4][2];
#pragma unroll
    for (int a = 0; a < 2; ++a)
#pragma unroll
        for (int b = 0; b < 2; ++b)
#pragma unroll
            for (int m = 0; m < 4; ++m)
#pragma unroll
                for (int n = 0; n < 2; ++n) acc[a][b][m][n] = (f32x4){0.f, 0.f, 0.f, 0.f};
    bf16x8 At[4][2], B0[2][2], B1[2][2];
    const char* cA = (const char*)g.A + (size_t)cur.pm * tstep; const char* cB = (const char*)g.Bt + (size_t)cur.pn * tstep;
    S.a_ready(cur);
    if constexpr (SP2) {
        PG8_STAGE(PG8_SB(0, 0), cB, voffB); PG8_STAGE(PG8_SB(0, 1), cB + hstep, voffB); PG8_STAGE(PG8_SA(0, 0), cA, voffA); PG8_STAGE(PG8_SA(0, 1), cA + hstep, voffA);
        if (wr == 1) PG8_BAR;
        PG8_WAIT_V(2); PG8_BAR;
        PG8_STAGE(PG8_SB(1, 0), cB + kstep, voffB); PG8_STAGE(PG8_SA(1, 0), cA + kstep, voffA); PG8_STAGE(PG8_SB(1, 1), cB + hstep + kstep, voffB);
        PG8_WAIT_V(6); PG8_BAR;
    } else {
        PG8_STAGE(PG8_SB(0, 0), cB, voffB); PG8_STAGE(PG8_SA(0, 0), cA, voffA); PG8_STAGE(PG8_SB(0, 1), cB + hstep, voffB); PG8_STAGE(PG8_SA(0, 1), cA + hstep, voffA);
        if (wr == 1) PG8_BAR;
        PG8_WAIT_V(4); PG8_BAR;
        PG8_STAGE(PG8_SB(1, 0), cB + kstep, voffB); PG8_STAGE(PG8_SA(1, 0), cA + kstep, voffA); PG8_STAGE(PG8_SB(1, 1), cB + hstep + kstep, voffB);
        PG8_WAIT_V(6); PG8_BAR;
    }
    for (;;) {
        const bool has_next = S.next(ui + 1, nxt);
        const char* nA = has_next ? (const char*)g.A + (size_t)nxt.pm * tstep : cA; const char* nB = has_next ? (const char*)g.Bt + (size_t)nxt.pn * tstep : cB;
        for (int t = 0; t < nt; t += 2) {
            const bool last = (t == nt - 2);
            const char* a1 = cA + (size_t)(t + 1) * kstep;
            const char* a2 = last ? nA : cA + (size_t)(t + 2) * kstep; const char* b2 = last ? nB : cB + (size_t)(t + 2) * kstep;
            const char* a3 = a2 + kstep; const char* b3 = b2 + kstep;
            if (last && has_next) S.a_ready(nxt);
            if constexpr (SP2) {
            PG8_LDB(B0, 0, 0); PG8_LDB(B1, 0, 1); PG8_SCHED; PG8_LDA(At, 0, 0); PG8_STAGE(PG8_SA(1, 1), a1 + hstep, voffA);
            PG8_WAIT_V(8); PG8_WAIT_L(0); PG8_BAR; PG8_MMA(0, 0, At, B0); PG8_MMA(0, 1, At, B1); PG8_BAR; PG8_SCHED;
            PG8_LDA(At, 0, 1); PG8_STAGE(PG8_SB(0, 0), b2, voffB); PG8_STAGE(PG8_SB(0, 1), b2 + hstep, voffB); PG8_STAGE(PG8_SA(0, 0), a2, voffA);
            PG8_WAIT_V(8); PG8_WAIT_L(0); PG8_BAR; PG8_MMA(1, 0, At, B0); PG8_MMA(1, 1, At, B1); PG8_BAR; PG8_SCHED;
            PG8_LDB(B0, 1, 0); PG8_LDB(B1, 1, 1); PG8_SCHED; PG8_LDA(At, 1, 0); PG8_STAGE(PG8_SA(0, 1), a2 + hstep, voffA);
            PG8_WAIT_V(8); PG8_WAIT_L(0); PG8_BAR; PG8_MMA(0, 0, At, B0); PG8_MMA(0, 1, At, B1); PG8_BAR; PG8_SCHED;
            PG8_LDA(At, 1, 1); PG8_STAGE(PG8_SB(1, 0), b3, voffB); PG8_STAGE(PG8_SB(1, 1), b3 + hstep, voffB); PG8_STAGE(PG8_SA(1, 0), a3, voffA);
            PG8_WAIT_V(8); PG8_WAIT_L(0); PG8_BAR; PG8_MMA(1, 0, At, B0); PG8_MMA(1, 1, At, B1); PG8_BAR; PG8_SCHED;
            } else {
            PG8_LDB(B0, 0, 0); PG8_SCHED; PG8_LDA(At, 0, 0); PG8_STAGE(PG8_SA(1, 1), a1 + hstep, voffA);
            PG8_WAIT_L(8); PG8_BAR; PG8_WAIT_L(0); PG8_MMA(0, 0, At, B0); PG8_BAR; PG8_SCHED;
            PG8_LDB(B1, 0, 1); PG8_STAGE(PG8_SB(0, 0), b2, voffB);
            PG8_BAR; PG8_WAIT_L(0); PG8_MMA(0, 1, At, B1); PG8_BAR;
            PG8_LDA(At, 0, 1); PG8_STAGE(PG8_SA(0, 0), a2, voffA);
            PG8_BAR; PG8_WAIT_L(0); PG8_MMA(1, 0, At, B0); PG8_BAR; PG8_SCHED;
            PG8_STAGE(PG8_SB(0, 1), b2 + hstep, voffB);
            PG8_WAIT_V(6); PG8_BAR; PG8_MMA(1, 1, At, B1); PG8_BAR;
            PG8_LDB(B0, 1, 0); PG8_SCHED; PG8_LDA(At, 1, 0); PG8_STAGE(PG8_SA(0, 1), a2 + hstep, voffA);
            PG8_WAIT_L(8); PG8_BAR; PG8_WAIT_L(0); PG8_MMA(0, 0, At, B0); PG8_BAR; PG8_SCHED;
            PG8_LDB(B1, 1, 1); PG8_STAGE(PG8_SB(1, 0), b3, voffB);
            PG8_BAR; PG8_WAIT_L(0); PG8_MMA(0, 1, At, B1); PG8_BAR;
            PG8_LDA(At, 1, 1); PG8_STAGE(PG8_SA(1, 0), a3, voffA);
            PG8_BAR; PG8_WAIT_L(0); PG8_MMA(1, 0, At, B0); PG8_BAR; PG8_SCHED;
            PG8_STAGE(PG8_SB(1, 1), b3 + hstep, voffB);
            PG8_WAIT_V(6); PG8_BAR; PG8_MMA(1, 1, At, B1); PG8_BAR;
            }
        }
        if constexpr (ALIGN_EPI) { if (wr == 0) PG8_BAR; }
        if constexpr (!Epi::AFTER_DRAIN) { E(acc, cur, wr, wc, fr, fq); S.done(cur); }
        if (!has_next) break;
#pragma unroll
        for (int a = 0; a < 2; ++a)
#pragma unroll
            for (int b = 0; b < 2; ++b)
#pragma unroll
                for (int m = 0; m < 4; ++m)
#pragma unroll
                    for (int n = 0; n < 2; ++n) acc[a][b][m][n] = (f32x4){0.f, 0.f, 0.f, 0.f};
        cur = nxt; cA = nA; cB = nB; ++ui;
        if constexpr (ALIGN_EPI) { if (wr == 1) PG8_BAR; }
    }
    PG8_WAIT_V(0);
    if constexpr (!ALIGN_EPI) { if (wr == 0) PG8_BAR; }
    PG8_BAR;
    if constexpr (Epi::AFTER_DRAIN) { E.fused(acc, cur, wr, wc, fr, fq, lds, wid, lane); S.done(cur); }
#undef PG8_SA
#undef PG8_SB
#undef PG8_STAGE
#undef PG8_LDA
#undef PG8_LDB
#undef PG8_MMA
#undef PG8_WAIT_V
#undef PG8_WAIT_L
#undef PG8_BAR
#undef PG8_SCHED
}
}
#ifndef PG8_SP2
#define PG8_SP2 true
#endif
#ifndef PG8_ALIGN
#define PG8_ALIGN true
#endif
#define GAS __attribute__((address_space(1)))
#define LAS __attribute__((address_space(3)))
typedef unsigned short bf16;
typedef unsigned v4u __attribute__((ext_vector_type(4)));
typedef float f32x4 __attribute__((ext_vector_type(4)));
typedef short bf16x8 __attribute__((ext_vector_type(8)));
typedef GAS unsigned gu32;
typedef GAS unsigned long long gu64;
#define RLX_AGENT __ATOMIC_RELAXED, __HIP_MEMORY_SCOPE_AGENT
#define LDS_WAIT() asm volatile("s_waitcnt lgkmcnt(0)" ::: "memory")
#define VM_WAIT() asm volatile("s_waitcnt vmcnt(0)" ::: "memory")
__device__ __forceinline__ unsigned long long rt() { return __builtin_amdgcn_s_memrealtime(); }
__device__ __forceinline__ unsigned f2bf(float f) { unsigned u = __builtin_bit_cast(unsigned, f); return (u + 0x7fffu + ((u >> 16) & 1u)) >> 16; }
__device__ __forceinline__ unsigned pk2(float lo, float hi) { return f2bf(lo) | (f2bf(hi) << 16); }

#define XB_TMO      128
#define XB_XCNT(j)  (256  + 64 * (j))
#define XB_XSUB(j)  (1280 + 64 * (j))
#define XB_XGEN(j)  (2304 + 64 * (j))
#define XB_TOP      3328
#define XB_TOPGEN   3392
#define XCD_BAR_WORDS 3456
#define XB_SPIN_CAP (1u << 18)

__device__ __forceinline__ unsigned xb_ld(unsigned* p)              { return __hip_atomic_load(p, __ATOMIC_RELAXED, __HIP_MEMORY_SCOPE_AGENT); }
__device__ __forceinline__ unsigned xb_add(unsigned* p, unsigned v) { return __hip_atomic_fetch_add(p, v, __ATOMIC_RELAXED, __HIP_MEMORY_SCOPE_AGENT); }
__device__ __forceinline__ unsigned xb_xcc_id() { return (unsigned)__builtin_amdgcn_s_getreg((3 << 11) | 20) & 0xFu; }
#define XB_SPIN(cond, bar) do { unsigned _sp = 0; while (cond) { __builtin_amdgcn_s_sleep(1); \
    if ((++_sp & 255u) == 0u) { if (xb_ld(&(bar)[XB_TMO])) break; if (_sp > XB_SPIN_CAP) { atomicAdd(&(bar)[XB_TMO], 1u); break; } } } } while (0)

struct XcdBarrier {
    unsigned* bar; unsigned x;
    volatile LAS unsigned* st;
};

__device__ __forceinline__ XcdBarrier xcd_barrier_post(unsigned* bar, volatile LAS unsigned* st) {
    XcdBarrier b; b.bar = bar; b.x = xb_xcc_id(); b.st = st;
    if (threadIdx.x == 0) (void)xb_add(&bar[XB_XCNT(b.x)], 1u);
    return b;
}
__device__ __forceinline__ void xcd_barrier_complete(unsigned* bar, unsigned x, unsigned& nloc, unsigned& nx) {
    const unsigned G = gridDim.x * gridDim.y * gridDim.z;
    unsigned sum, cnt, mine, sp = 0u;
    for (;;) {
        sum = 0u; cnt = 0u; mine = 0u;
#pragma unroll
        for (unsigned j = 0; j < 16; ++j) { const unsigned c = xb_ld(&bar[XB_XCNT(j)]); sum += c; cnt += (c > 0u) ? 1u : 0u; mine = (j == x) ? c : mine; }
        if (sum == G) break;
        __builtin_amdgcn_s_sleep(1);
        if ((++sp & 255u) == 0u) { if (xb_ld(&bar[XB_TMO])) break; if (sp > XB_SPIN_CAP) { atomicAdd(&bar[XB_TMO], 1u); break; } }
    }
    nloc = mine > 0u ? mine : 1u; nx = cnt > 0u ? cnt : 1u;
}

__device__ __forceinline__ void xcd_barrier(const XcdBarrier& b) {
    asm volatile("s_waitcnt vmcnt(0)" ::: "memory");
    __syncthreads();
    if (threadIdx.x == 0) {
        unsigned* bar = b.bar;
        __builtin_amdgcn_s_waitcnt(0);
        unsigned nloc = b.st[0], nx = b.st[1];
        if (nloc == 0u) { xcd_barrier_complete(bar, b.x, nloc, nx); b.st[0] = nloc; b.st[1] = nx; }
        const unsigned old = xb_add(&bar[XB_XSUB(b.x)], 1u);
        const unsigned gen = old / nloc;
        if (old + 1u == (gen + 1u) * nloc) {
            __builtin_amdgcn_fence(__ATOMIC_RELEASE, "agent");
            asm volatile("s_waitcnt vmcnt(0)" ::: "memory");
            const unsigned og = xb_add(&bar[XB_TOP], 1u);
            const unsigned tg = og / nx;
            if (og + 1u == (tg + 1u) * nx) xb_add(&bar[XB_TOPGEN], 1u);
            else XB_SPIN(xb_ld(&bar[XB_TOPGEN]) == tg, bar);
            __builtin_amdgcn_fence(__ATOMIC_ACQUIRE, "agent");
            xb_add(&bar[XB_XGEN(b.x)], 1u);
            asm volatile("s_waitcnt vmcnt(0)" ::: "memory");
        } else {
            XB_SPIN(xb_ld(&bar[XB_XGEN(b.x)]) == gen, bar);
            __builtin_amdgcn_fence(__ATOMIC_ACQUIRE, "agent");
            asm volatile("s_waitcnt vmcnt(0)" ::: "memory");
        }
    }
    __syncthreads();
}

constexpr int DM = 1024;
constexpr int MCTX = 4096, MLAT = 16384, MTOK = 20480;
constexpr int NZ = 2048;
constexpr int DFF = 2816, NGU = 5632, PIN = 2304;
constexpr int WIN_ROWS = 2560;
constexpr int MODW = 6144;
constexpr float LN_EPS = 1e-6f;
constexpr float ALPHA_RES = 1.41421356237309515f;
constexpr float LOG2E = 1.4426950408889634f;
constexpr float QSCALE = 0.125f * LOG2E;

constexpr size_t MiB = 1u << 20;
constexpr size_t WS_CTL = 0, CTL_ZERO_BYTES = 65536;
constexpr size_t WS_MOD = 1 * MiB;
constexpr size_t WS_AWS = 1 * MiB + 512 * 1024;
constexpr size_t WS_DFT256 = 1 * MiB + 768 * 1024;
constexpr size_t WS_WIN = 2 * MiB;
constexpr size_t WS_H = 12 * MiB;
constexpr size_t WS_WOUT = 52 * MiB;
constexpr size_t WS_WGU = 56 * MiB;
constexpr size_t WS_WDN = 78 * MiB;
constexpr size_t WS_DFT = 89 * MiB;
constexpr size_t WS_EDGE = 105 * MiB;
constexpr size_t WS_Z = 111 * MiB;
constexpr size_t WS_PQL = 191 * MiB;
constexpr size_t WS_PQC = 207 * MiB;
constexpr size_t WS_MIX = 211 * MiB;
constexpr size_t WS_ACT = 111 * MiB;
constexpr size_t WS_END = 251 * MiB;
static_assert(WS_WIN + (size_t)2 * WIN_ROWS * DM * 2 == WS_H, "H must follow Win_t");
static_assert(WS_ACT + (size_t)MTOK * DFF * 2 <= WS_END, "ACT fits");
constexpr int CW_TMO = 0, CW_CODE = 1, CW_BAR = 4096, CW_QUEUE = 8192;

constexpr int RING_OFF = 0, RING_BYTES = 131072;
constexpr int XTRA_OFF = RING_BYTES;
constexpr int LDSCTL_OFF = RING_BYTES + 8192, MISC_OFF = LDSCTL_OFF + 320;
constexpr int LDS_BYTES = 147456;
constexpr int NWAVES = 8;

typedef unsigned short bf16;

__device__ __forceinline__ float bf2f(unsigned short b) { return __uint_as_float(((unsigned)b) << 16); }
__device__ __forceinline__ float bflo(unsigned w) { return __uint_as_float(w << 16); }
__device__ __forceinline__ float bfhi(unsigned w) { return __uint_as_float(w & 0xffff0000u); }
__device__ __forceinline__ unsigned pkbf(float lo, float hi) { return pg8::cvt_pk_bf16(lo, hi); }
__device__ __forceinline__ float fast_exp2(float x) { return __builtin_amdgcn_exp2f(x); }
__device__ __forceinline__ float fast_rcp(float x) { return __builtin_amdgcn_rcpf(x); }
__device__ __forceinline__ float gelu_tanh(float x) {
    const float u = 0.7978845608028654f * (x + 0.044715f * x * x * x);
    const float e = fast_exp2(-2.0f * LOG2E * u);
    return x * fast_rcp(1.0f + e);
}
__device__ __forceinline__ float silu_f(float x) { return x * fast_rcp(1.0f + fast_exp2(-LOG2E * x)); }
__device__ __forceinline__ int seq_of_tile(int pm) { return pm < 16 ? 0 : 1 + ((pm - 16) >> 3); }

struct SchedP1 {
    int G, c, pmH;
    __device__ __forceinline__ bool next(int i, pg8::Unit& u) const {
        const int L = i * G + c; if (L >= 800) return false;
        if (L < 640) {
            int wgid = L; { const int q = 640 / 8, xcd = wgid % 8, off = wgid / 8; wgid = xcd * q + off; }
            const int nig = 8 * 8, gid = wgid / nig, fm = gid * 8;
            u.pm = pmH + fm + ((wgid % nig) % 8); u.pn = (wgid % nig) / 8;
        } else { const int Lp = L - 640; u.pm = 8 + (Lp & 1); u.pn = pmH + (Lp >> 1); }
        return true;
    }
    __device__ __forceinline__ void a_ready(const pg8::Unit&) const {}
    __device__ __forceinline__ void done(const pg8::Unit&) const {}
};
struct OneUnit {
    pg8::Unit u0;
    __device__ __forceinline__ bool next(int i, pg8::Unit& u) const { if (i != 0) return false; u = u0; return true; }
    __device__ __forceinline__ void a_ready(const pg8::Unit&) const {}
    __device__ __forceinline__ void done(const pg8::Unit&) const {}
};

typedef unsigned u32x4v __attribute__((ext_vector_type(4)));
typedef unsigned u32x2v __attribute__((ext_vector_type(2)));


struct EpiZ {
    static constexpr bool PERM = true, AFTER_DRAIN = false;
    bf16* Z; bf16* PQL; bf16* PQC; float* newk; float* newv; int layer, pmH;
    __device__ __forceinline__ void operator()(const f32x4 (&acc)[2][2][4][2], const pg8::Unit& u, int wr, int wc, int fr, int fq) const {
        if (u.pm >= pmH) {
            const int tm = u.pm - pmH, pn = u.pn;
            const int row0 = tm * 256 + wr * 64 + fr, col0 = pn * 256 + wc * 32 + 8 * fq;
#pragma unroll
            for (int ai = 0; ai < 2; ++ai)
#pragma unroll
                for (int m = 0; m < 4; ++m) {
                    const int R = row0 + ai * 128 + m * 16;
#pragma unroll
                    for (int bj = 0; bj < 2; ++bj) {
                        const int c = col0 + bj * 128;
                        f32x4 v0 = acc[ai][bj][m][0], v1 = acc[ai][bj][m][1];
                        if (pn >= 4 && tm < 16) {
                            float* dst = (pn < 6 ? newk : newv) + ((size_t)((tm * 2 + layer) * 256 + (R & 255)) * 512 + (c - (pn < 6 ? 1024 : 1536)));
                            *(f32x4*)dst = v0; *(f32x4*)(dst + 4) = v1;
                        }
                        if (pn < 2) {
#pragma unroll
                            for (int j = 0; j < 4; ++j) { v0[j] = gelu_tanh(v0[j]); v1[j] = gelu_tanh(v1[j]); }
                        } else if (pn < 4) { v0 = v0 * QSCALE; v1 = v1 * QSCALE; }
                        u32x4v w; w.x = pkbf(v0[0], v0[1]); w.y = pkbf(v0[2], v0[3]); w.z = pkbf(v1[0], v1[1]); w.w = pkbf(v1[2], v1[3]);
                        *(u32x4v*)(Z + (size_t)R * NZ + c) = w;
                    }
                }
        } else {
            const int pq = u.pm - 8, tn = u.pn - pmH;
            const int nrow0 = wr * 64 + fr, tok0 = tn * 256 + wc * 32 + 8 * fq;
            bf16* base; int ld;
            if (tn < 16) { base = PQC + (size_t)tn * 256 * 512 + pq * 256; ld = 512; }
            else { base = PQL + (size_t)((tn - 16) >> 3) * 256 * 4096 + pq * 2048 + ((tn - 16) & 7) * 256; ld = 4096; }
#pragma unroll
            for (int ai = 0; ai < 2; ++ai)
#pragma unroll
                for (int m = 0; m < 4; ++m) {
                    const int nrow = nrow0 + ai * 128 + m * 16;
#pragma unroll
                    for (int bj = 0; bj < 2; ++bj) {
                        const int t = (tok0 & 255) + bj * 128;
                        const f32x4 v0 = acc[ai][bj][m][0], v1 = acc[ai][bj][m][1];
                        u32x4v w; w.x = pkbf(v0[0], v0[1]); w.y = pkbf(v0[2], v0[3]); w.z = pkbf(v1[0], v1[1]); w.w = pkbf(v1[2], v1[3]);
                        *(u32x4v*)(base + (size_t)nrow * ld + t) = w;
                    }
                }
        }
    }
};

struct EpiRes {
    static constexpr bool PERM = false, AFTER_DRAIN = false;
    const float* xctx; const float* xlat; float* XB; const float* gate;
    __device__ __forceinline__ void operator()(const f32x4 (&acc)[2][2][4][2], const pg8::Unit& u, int wr, int wc, int fr, int fq) const {
        const int row0 = u.pm * 256 + wr * 64 + fr, col0 = u.pn * 256 + wc * 32 + 4 * fq;
        const float* gp = gate + (size_t)seq_of_tile(u.pm) * MODW + col0;
        f32x4 gv[2][2];
#pragma unroll
        for (int bj = 0; bj < 2; ++bj)
#pragma unroll
            for (int n = 0; n < 2; ++n) gv[bj][n] = *(const f32x4*)(gp + bj * 128 + n * 16);
#pragma unroll
        for (int ai = 0; ai < 2; ++ai)
#pragma unroll
            for (int m = 0; m < 4; ++m) {
                const int R = row0 + ai * 128 + m * 16;
                const float* xs = (R < MCTX ? xctx + (size_t)R * DM : xlat + (size_t)(R - MCTX) * DM) + col0;
                float* xo = XB + (size_t)R * DM + col0;
#pragma unroll
                for (int bj = 0; bj < 2; ++bj)
#pragma unroll
                    for (int n = 0; n < 2; ++n) {
                        const f32x4 xv = *(const f32x4*)(xs + bj * 128 + n * 16);
                        *(f32x4*)(xo + bj * 128 + n * 16) = xv * ALPHA_RES + gv[bj][n] * acc[ai][bj][m][n];
                    }
            }
    }
};

struct EpiFourier {
    static constexpr bool PERM = true, AFTER_DRAIN = false;
    bf16* MIX; int rowbase, pnstride;
    __device__ __forceinline__ void operator()(const f32x4 (&acc)[2][2][4][2], const pg8::Unit& u, int wr, int wc, int fr, int fq) const {
        const int row0 = rowbase + u.pn * pnstride + u.pm * 256 + wr * 64 + fr, col0 = 256 + wc * 32 + 8 * fq;
#pragma unroll
        for (int ai = 0; ai < 2; ++ai)
#pragma unroll
            for (int m = 0; m < 4; ++m) {
                bf16* rowp = MIX + (size_t)(row0 + ai * 128 + m * 16) * DM + col0;
#pragma unroll
                for (int bj = 0; bj < 2; ++bj) {
                    const f32x4 v0 = acc[ai][bj][m][0], v1 = acc[ai][bj][m][1];
                    u32x4v w; w.x = pkbf(v0[0], v0[1]); w.y = pkbf(v0[2], v0[3]); w.z = pkbf(v1[0], v1[1]); w.w = pkbf(v1[2], v1[3]);
                    *(u32x4v*)(rowp + bj * 128) = w;
                }
            }
    }
};

struct EpiConv {
    static constexpr bool PERM = true, AFTER_DRAIN = false;
    bf16* ACT; float* EDGE; const float* cw; const float* cb; PG8_LAS float* xl;
    __device__ __forceinline__ void operator()(const f32x4 (&acc)[2][2][4][2], const pg8::Unit& u, int wr, int wc, int fr_, int fq_) const {
        int fr = fr_, fq = fq_; asm volatile("" : "+v"(fr), "+v"(fq));
        const int chl = wc * 32 + 8 * fq, ch0 = u.pn * 128 + chl, lane = fq * 16 + fr;
#pragma unroll
        for (int ai = 0; ai < 2; ++ai) {
            const int blk = ai * 2 + wr;
            if (fr == 0) { *(PG8_LAS f32x4*)(xl + (blk * 2 + 0) * 128 + chl) = acc[ai][0][0][0]; *(PG8_LAS f32x4*)(xl + (blk * 2 + 0) * 128 + chl + 4) = acc[ai][0][0][1]; }
            if (fr == 15) { *(PG8_LAS f32x4*)(xl + (blk * 2 + 1) * 128 + chl) = acc[ai][0][3][0]; *(PG8_LAS f32x4*)(xl + (blk * 2 + 1) * 128 + chl + 4) = acc[ai][0][3][1]; }
        }
        {
            float* eb = EDGE + (size_t)u.pm * 6 * DFF + ch0;
            if (wr == 0 && fr == 0) { *(f32x4*)(eb + 0 * DFF) = acc[0][0][0][0]; *(f32x4*)(eb + 0 * DFF + 4) = acc[0][0][0][1]; *(f32x4*)(eb + 2 * DFF) = acc[0][1][0][0]; *(f32x4*)(eb + 2 * DFF + 4) = acc[0][1][0][1]; }
            if (wr == 0 && fr == 1) { *(f32x4*)(eb + 1 * DFF) = acc[0][0][0][0]; *(f32x4*)(eb + 1 * DFF + 4) = acc[0][0][0][1]; }
            if (wr == 1 && fr == 15) { *(f32x4*)(eb + 3 * DFF) = acc[1][0][3][0]; *(f32x4*)(eb + 3 * DFF + 4) = acc[1][0][3][1]; *(f32x4*)(eb + 5 * DFF) = acc[1][1][3][0]; *(f32x4*)(eb + 5 * DFF + 4) = acc[1][1][3][1]; }
            if (wr == 1 && fr == 14) { *(f32x4*)(eb + 4 * DFF) = acc[1][0][3][0]; *(f32x4*)(eb + 4 * DFF + 4) = acc[1][0][3][1]; }
        }
        asm volatile("s_waitcnt lgkmcnt(0)" ::: "memory"); __builtin_amdgcn_s_barrier(); asm volatile("" ::: "memory");
        f32x4 w0[2], w1[2], w2[2], cbv[2];
#pragma unroll
        for (int n = 0; n < 2; ++n) { w0[n] = *(const f32x4*)(cw + ch0 + 4 * n); w1[n] = *(const f32x4*)(cw + DFF + ch0 + 4 * n); w2[n] = *(const f32x4*)(cw + 2 * DFF + ch0 + 4 * n); cbv[n] = *(const f32x4*)(cb + ch0 + 4 * n); }
        const int lprev = (lane & 48) | ((lane - 1) & 15), lnext = (lane & 48) | ((lane + 1) & 15);
#pragma unroll
        for (int ai = 0; ai < 2; ++ai) {
            const int blk = ai * 2 + wr;
            f32x4 top[2], bot[2];
#pragma unroll
            for (int n = 0; n < 2; ++n) {
                top[n] = blk > 0 ? *(const PG8_LAS f32x4*)(xl + ((blk - 1) * 2 + 1) * 128 + chl + 4 * n) : (f32x4){0.f, 0.f, 0.f, 0.f};
                bot[n] = blk < 3 ? *(const PG8_LAS f32x4*)(xl + ((blk + 1) * 2 + 0) * 128 + chl + 4 * n) : (f32x4){0.f, 0.f, 0.f, 0.f};
            }
#pragma unroll
            for (int n = 0; n < 2; ++n) {
                f32x4 A[4], B[4];
#pragma unroll
                for (int m = 0; m < 4; ++m)
#pragma unroll
                    for (int e = 0; e < 4; ++e) { A[m][e] = __shfl(acc[ai][0][m][n][e], lprev); B[m][e] = __shfl(acc[ai][0][m][n][e], lnext); }
#pragma unroll
                for (int m = 0; m < 4; ++m) {
                    const f32x4 up = (fr != 0) ? A[m] : (m == 0 ? top[n] : A[m == 0 ? 0 : m - 1]);
                    const f32x4 dn = (fr != 15) ? B[m] : (m == 3 ? bot[n] : B[m == 3 ? 3 : m + 1]);
                    const f32x4 gc = cbv[n] + w0[n] * up + w1[n] * acc[ai][0][m][n] + w2[n] * dn;
                    f32x4 o;
#pragma unroll
                    for (int e = 0; e < 4; ++e) o[e] = silu_f(gc[e]) * acc[ai][1][m][n][e];
                    const int R = u.pm * 256 + ai * 128 + wr * 64 + m * 16 + fr;
                    u32x2v w; w.x = pkbf(o[0], o[1]); w.y = pkbf(o[2], o[3]);
                    *(u32x2v*)(ACT + (size_t)R * DFF + ch0 + 4 * n) = w;
                }
            }
        }
    }
};

struct Args {
    const float* in[22];
    float* out; unsigned char* ws;
    int ph_lo, ph_hi;
};
enum { I_XP = 0, I_XS, I_CK, I_CV, I_C, I_CCTX, I_WADA, I_BADA, I_WIN, I_AWS, I_ABS, I_FW, I_RPB, I_WOUT, I_LN1G, I_LN1B, I_WGU, I_CONVW, I_CONVB, I_WDOWN, I_LN2G, I_LN2B };
constexpr int NPHASE = 18;

__device__ __forceinline__ float wave_sum(float v) {
#pragma unroll
    for (int o = 1; o < 64; o <<= 1) v += __shfl_xor(v, o);
    return v;
}
typedef unsigned v4u __attribute__((ext_vector_type(4)));

__device__ __forceinline__ void transpose_item(const float* W, int ldw, bf16* WT, int dst_ld, int k0, int n0, int dstrow0, LAS float* scr, int lane) {
    float tv[32];
#pragma unroll
    for (int i = 0; i < 32; ++i) { const int kk = 2 * i + (lane >> 5); tv[i] = W[(size_t)(k0 + kk) * ldw + n0 + (lane & 31)]; }
#pragma unroll
    for (int i = 0; i < 32; ++i) { const int kk = 2 * i + (lane >> 5); scr[kk * 33 + (lane & 31)] = tv[i]; }
    LDS_WAIT(); asm volatile("" ::: "memory");
    const int c = lane & 7;
#pragma unroll
    for (int j = 0; j < 4; ++j) { const int n = (lane >> 3) + 8 * j; const LAS float* s = scr + (8 * c) * 33 + n;
        v4u o; o.x = pk2(s[0 * 33], s[1 * 33]); o.y = pk2(s[2 * 33], s[3 * 33]); o.z = pk2(s[4 * 33], s[5 * 33]); o.w = pk2(s[6 * 33], s[7 * 33]);
        *(GAS v4u*)(WT + (size_t)(dstrow0 + n) * dst_ld + k0 + 8 * c) = o; }
    LDS_WAIT(); asm volatile("" ::: "memory");
}

__device__ __forceinline__ void ln_row_regs(f32x4 (&v)[4], float* xdst, const float* g, const float* bb, bf16* hdst, const float* shift, const float* scale, int lane) {
    if (xdst) {
        float s = 0.f;
#pragma unroll
        for (int j = 0; j < 4; ++j) s += (v[j][0] + v[j][1]) + (v[j][2] + v[j][3]);
        const float mean = wave_sum(s) * (1.f / DM); float s2 = 0.f;
#pragma unroll
        for (int j = 0; j < 4; ++j) { v[j] = v[j] - mean; s2 += (v[j][0] * v[j][0] + v[j][1] * v[j][1]) + (v[j][2] * v[j][2] + v[j][3] * v[j][3]); }
        const float rstd = 1.f / sqrtf(wave_sum(s2) * (1.f / DM) + LN_EPS);
#pragma unroll
        for (int j = 0; j < 4; ++j) { const f32x4 gg = *((const f32x4*)g + lane + 64 * j), bv = *((const f32x4*)bb + lane + 64 * j); v[j] = v[j] * rstd * gg + bv; *((f32x4*)xdst + lane + 64 * j) = v[j]; }
    }
    if (hdst) {
        float s = 0.f;
#pragma unroll
        for (int j = 0; j < 4; ++j) s += (v[j][0] + v[j][1]) + (v[j][2] + v[j][3]);
        const float mean = wave_sum(s) * (1.f / DM); float s2 = 0.f;
#pragma unroll
        for (int j = 0; j < 4; ++j) { v[j] = v[j] - mean; s2 += (v[j][0] * v[j][0] + v[j][1] * v[j][1]) + (v[j][2] * v[j][2] + v[j][3] * v[j][3]); }
        const float rstd = 1.f / sqrtf(wave_sum(s2) * (1.f / DM) + LN_EPS);
#pragma unroll
        for (int j = 0; j < 4; ++j) { const f32x4 sc = *((const f32x4*)scale + lane + 64 * j), sh = *((const f32x4*)shift + lane + 64 * j);
            const f32x4 h = v[j] * rstd * (sc + 1.0f) + sh; u32x2v w; w.x = pkbf(h[0], h[1]); w.y = pkbf(h[2], h[3]);
            *((u32x2v*)hdst + lane + 64 * j) = w; }
    }
}
__device__ __forceinline__ void ln_pass(int kind, int l, const float* xp, const float* xs, float* XB, const float* MOD, const float* gg, const float* bb, bf16* H, int gw, int NGW, int lane) {
    const bool wantx = kind != 0, wanth = kind != 2 || l == 0;
#define srcrow(m_) (kind == 0 ? ((m_) < MCTX ? xp + (size_t)(m_) * DM : xs + (size_t)((m_) - MCTX) * DM) : (const float*)(XB + (size_t)(m_) * DM))
    f32x4 c0[4], c1[4], n0[4], n1[4];
    int m = gw;
    if (m < MTOK) {
#pragma unroll
        for (int j = 0; j < 4; ++j) { c0[j] = *((const f32x4*)srcrow(m) + lane + 64 * j); c1[j] = (m + NGW < MTOK) ? *((const f32x4*)srcrow(m + NGW) + lane + 64 * j) : (f32x4){0.f, 0.f, 0.f, 0.f}; }
    }
    for (; m < MTOK; m += 2 * NGW) {
        const int mn = m + 2 * NGW;
        if (mn < MTOK) {
#pragma unroll
            for (int j = 0; j < 4; ++j) { n0[j] = *((const f32x4*)srcrow(mn) + lane + 64 * j); n1[j] = (mn + NGW < MTOK) ? *((const f32x4*)srcrow(mn + NGW) + lane + 64 * j) : (f32x4){0.f, 0.f, 0.f, 0.f}; }
        }
#define LN_ONE(mm_, regs_) do { const int mm = (mm_); if (mm < MTOK) { const int s = mm < MCTX ? 0 : 1 + ((mm - MCTX) >> 11); \
            const float* modp = kind == 0 ? MOD + (size_t)s * MODW : (kind == 2 ? MOD + (size_t)(9 + s) * MODW : MOD + (size_t)(l * 9 + s) * MODW + 3072); \
            float* xr = XB + (size_t)mm * DM; \
            ln_row_regs(regs_, wantx ? xr : nullptr, gg, bb, wanth ? H + (size_t)mm * DM : nullptr, modp, modp + 1024, lane); } } while (0)
        LN_ONE(m, c0); LN_ONE(m + NGW, c1);
#undef LN_ONE
#pragma unroll
        for (int j = 0; j < 4; ++j) { c0[j] = n0[j]; c1[j] = n1[j]; }
    }
#undef srcrow
}

typedef short bf16x8v __attribute__((ext_vector_type(8)));
typedef float f32x16 __attribute__((ext_vector_type(16)));
constexpr int AT_KS = 0, AT_VT = 9216, AT_RPB = 18432;
__device__ __forceinline__ int crow(int r, int hh) { return (r & 3) + 8 * (r >> 2) + 4 * hh; }

template <bool LAT>
__device__ __forceinline__ void attn_unit(LAS unsigned char* lds, const bf16* Z, const float* ck, const float* cv, const float* rpb, bf16* MIX, int b, int h, int R4, int tid) {
    const int lane = tid & 63, w = __builtin_amdgcn_readfirstlane(tid >> 6), r32 = lane & 31, hh = lane >> 5;
    LAS bf16* KS = (LAS bf16*)(lds + AT_KS); LAS bf16* VT = (LAS bf16*)(lds + AT_VT); LAS float* RPBL = (LAS float*)(lds + AT_RPB);
    int qrow = 0, qcol = 0; size_t Rq;
    if (LAT) { qrow = 4 * R4 + (w >> 1); qcol = 32 * (w & 1) + r32; Rq = (size_t)MCTX + (size_t)b * 2048 + qrow * 64 + qcol; }
    else Rq = (size_t)b * 256 + w * 32 + r32;
    __syncthreads();
    if (LAT) { for (int i = tid; i < 465; i += 512) RPBL[i] = rpb[h * 465 + i] * LOG2E; }
    bf16x8v qf[4];
#pragma unroll
    for (int d0 = 0; d0 < 4; ++d0) qf[d0] = *(const bf16x8v*)(Z + Rq * NZ + 512 + 64 * h + 16 * d0 + 8 * hh);
    int kr_lo = 0, nloc = 0, rsw = 0;
    if (LAT) { const int r0 = 4 * R4; kr_lo = min(max(r0 - 4, 0), 24); const int kr_hi = min(max(r0 + 3 - 4, 0), 24) + 7; nloc = kr_hi - kr_lo + 1; rsw = min(max(qrow - 4, 0), 24); }
    const int NT = LAT ? 8 + nloc : 4;
    const int lkey = tid >> 3, lch = tid & 7;
    const int vpos = (lkey & ~15) | (8 * ((lkey >> 2) & 1) + 4 * ((lkey >> 3) & 1) + (lkey & 3));
    u32x4v kreg, vreg;
#define LOAD_TILE(t_) do { const int t__ = (t_); \
        if (LAT && t__ < 8) { \
            const size_t off = ((size_t)(b * 2) * 512 + (size_t)(64 * t__ + lkey)) * 512 + 64 * h + 8 * lch;     \
            const f32x4 a0 = *(const f32x4*)(ck + off), a1 = *(const f32x4*)(ck + off + 4), c0 = *(const f32x4*)(cv + off), c1 = *(const f32x4*)(cv + off + 4); \
            kreg.x = pkbf(a0[0], a0[1]); kreg.y = pkbf(a0[2], a0[3]); kreg.z = pkbf(a1[0], a1[1]); kreg.w = pkbf(a1[2], a1[3]); \
            vreg.x = pkbf(c0[0], c0[1]); vreg.y = pkbf(c0[2], c0[3]); vreg.z = pkbf(c1[0], c1[1]); vreg.w = pkbf(c1[2], c1[3]); \
        } else { \
            const size_t Rk = LAT ? (size_t)MCTX + (size_t)b * 2048 + (size_t)(kr_lo + (t__ - 8)) * 64 + lkey : (size_t)b * 256 + 64 * t__ + lkey; \
            kreg = *(const u32x4v*)(Z + Rk * NZ + 1024 + 64 * h + 8 * lch); \
            vreg = *(const u32x4v*)(Z + Rk * NZ + 1536 + 64 * h + 8 * lch); \
        } } while (0)
    float mrun = -INFINITY, lrun = 0.f;
    f32x16 o0, o1;
#pragma unroll
    for (int r = 0; r < 16; ++r) { o0[r] = 0.f; o1[r] = 0.f; }
    LOAD_TILE(0);
    for (int t = 0; t < NT; ++t) {
        __syncthreads();
        *(LAS u32x4v*)(KS + lkey * 72 + 8 * lch) = kreg;
        {
            LAS bf16* vp = VT + (8 * lch) * 72 + vpos;
            vp[0 * 72] = (bf16)(vreg.x & 0xffff); vp[1 * 72] = (bf16)(vreg.x >> 16); vp[2 * 72] = (bf16)(vreg.y & 0xffff); vp[3 * 72] = (bf16)(vreg.y >> 16);
            vp[4 * 72] = (bf16)(vreg.z & 0xffff); vp[5 * 72] = (bf16)(vreg.z >> 16); vp[6 * 72] = (bf16)(vreg.w & 0xffff); vp[7 * 72] = (bf16)(vreg.w >> 16);
        }
        __syncthreads();
        if (t + 1 < NT) LOAD_TILE(t + 1);
        const bool local = LAT && t >= 8;
        const int kr = kr_lo + (t - 8);
        if (local && (kr < rsw || kr > rsw + 7)) continue;
        f32x16 p0, p1;
#pragma unroll
        for (int r = 0; r < 16; ++r) { p0[r] = 0.f; p1[r] = 0.f; }
#pragma unroll
        for (int d0 = 0; d0 < 4; ++d0) {
            const bf16x8v k0 = *(const LAS bf16x8v*)(KS + r32 * 72 + 16 * d0 + 8 * hh);
            const bf16x8v k1 = *(const LAS bf16x8v*)(KS + (32 + r32) * 72 + 16 * d0 + 8 * hh);
            p0 = __builtin_amdgcn_mfma_f32_32x32x16_bf16(k0, qf[d0], p0, 0, 0, 0);
            p1 = __builtin_amdgcn_mfma_f32_32x32x16_bf16(k1, qf[d0], p1, 0, 0, 0);
        }
        if (local) {
            const int cs = min(max(qcol - 8, 0), 48);
            const int rbase = (kr - qrow + 7) * 31 + 15 - qcol;
#pragma unroll
            for (int r = 0; r < 16; ++r) {
                const int kc0 = crow(r, hh), kc1 = kc0 + 32;
                const bool v0 = (unsigned)(kc0 - cs) < 16u, v1 = (unsigned)(kc1 - cs) < 16u;
                const float b0 = RPBL[v0 ? rbase + kc0 : 0], b1 = RPBL[v1 ? rbase + kc1 : 0];
                p0[r] = v0 ? p0[r] + b0 : -INFINITY; p1[r] = v1 ? p1[r] + b1 : -INFINITY;
            }
        }
        float tmax = fmaxf(p0[0], p1[0]);
#pragma unroll
        for (int r = 1; r < 16; ++r) tmax = fmaxf(tmax, fmaxf(p0[r], p1[r]));
        tmax = fmaxf(tmax, __shfl_xor(tmax, 32));
        const float mnew = fmaxf(mrun, tmax);
        const float alpha = fast_exp2(mrun - mnew);
        mrun = mnew;
        float ls = 0.f;
#pragma unroll
        for (int r = 0; r < 16; ++r) { p0[r] = fast_exp2(p0[r] - mnew); p1[r] = fast_exp2(p1[r] - mnew); ls += p0[r] + p1[r]; }
        lrun = lrun * alpha + ls;
#pragma unroll
        for (int r = 0; r < 16; ++r) { o0[r] *= alpha; o1[r] *= alpha; }
        bf16x8v pb[4];
#pragma unroll
        for (int s = 0; s < 2; ++s) {
            u32x4v a, c;
            a.x = pkbf(p0[8 * s + 0], p0[8 * s + 1]); a.y = pkbf(p0[8 * s + 2], p0[8 * s + 3]); a.z = pkbf(p0[8 * s + 4], p0[8 * s + 5]); a.w = pkbf(p0[8 * s + 6], p0[8 * s + 7]);
            c.x = pkbf(p1[8 * s + 0], p1[8 * s + 1]); c.y = pkbf(p1[8 * s + 2], p1[8 * s + 3]); c.z = pkbf(p1[8 * s + 4], p1[8 * s + 5]); c.w = pkbf(p1[8 * s + 6], p1[8 * s + 7]);
            pb[s] = __builtin_bit_cast(bf16x8v, a); pb[2 + s] = __builtin_bit_cast(bf16x8v, c);
        }
#pragma unroll
        for (int ks = 0; ks < 4; ++ks) {
            const bf16x8v va = *(const LAS bf16x8v*)(VT + r32 * 72 + 16 * ks + 8 * hh);
            const bf16x8v vb = *(const LAS bf16x8v*)(VT + (32 + r32) * 72 + 16 * ks + 8 * hh);
            o0 = __builtin_amdgcn_mfma_f32_32x32x16_bf16(va, pb[ks], o0, 0, 0, 0);
            o1 = __builtin_amdgcn_mfma_f32_32x32x16_bf16(vb, pb[ks], o1, 0, 0, 0);
        }
    }
    lrun += __shfl_xor(lrun, 32);
    const float inv = 1.0f / lrun;
    bf16* op = MIX + Rq * DM + 512 + 64 * h + 4 * hh;
#pragma unroll
    for (int g4 = 0; g4 < 4; ++g4) {
        u32x2v a, c;
        a.x = pkbf(o0[4 * g4 + 0] * inv, o0[4 * g4 + 1] * inv); a.y = pkbf(o0[4 * g4 + 2] * inv, o0[4 * g4 + 3] * inv);
        c.x = pkbf(o1[4 * g4 + 0] * inv, o1[4 * g4 + 1] * inv); c.y = pkbf(o1[4 * g4 + 2] * inv, o1[4 * g4 + 3] * inv);
        *(u32x2v*)(op + 8 * g4) = a; *(u32x2v*)(op + 32 + 8 * g4) = c;
    }
}

#undef LOAD_TILE
constexpr int GM_PITCH = 136;
__device__ __forceinline__ void gmlp_unit(LAS unsigned char* lds, const bf16* Z, const bf16* AWS  , const float* abs_  , bf16* MIX, int cidx, int tid) {
    const int lane = tid & 63, w = __builtin_amdgcn_readfirstlane(tid >> 6), r32 = lane & 31, hh = lane >> 5;
    LAS bf16* VT = (LAS bf16*)lds;
    const size_t R0 = (size_t)cidx * 128;
    __syncthreads();
    for (int i = 0; i < 16; ++i) {
        const int q = w * 16 + i;
        const u32x2v raw = *(const u32x2v*)(Z + (R0 + q) * NZ + 256 + 4 * lane);
        float x0 = bflo(raw.x), x1 = bfhi(raw.x), x2 = bflo(raw.y), x3 = bfhi(raw.y);
        const float mean = wave_sum((x0 + x1) + (x2 + x3)) * (1.f / 256.f);
        x0 -= mean; x1 -= mean; x2 -= mean; x3 -= mean;
        const float rstd = 1.f / sqrtf(wave_sum((x0 * x0 + x1 * x1) + (x2 * x2 + x3 * x3)) * (1.f / 256.f) + LN_EPS);
        const unsigned a = pkbf(x0 * rstd, x1 * rstd), c = pkbf(x2 * rstd, x3 * rstd);
        LAS bf16* vp = VT + (4 * lane) * GM_PITCH + q;
        vp[0] = (bf16)(a & 0xffff); vp[GM_PITCH] = (bf16)(a >> 16); vp[2 * GM_PITCH] = (bf16)(c & 0xffff); vp[3 * GM_PITCH] = (bf16)(c >> 16);
    }
    __syncthreads();
    const int h = w >> 1, chb = 64 * h + 32 * (w & 1);
    f32x16 acc[4];
#pragma unroll
    for (int nt = 0; nt < 4; ++nt)
#pragma unroll
        for (int r = 0; r < 16; ++r) acc[nt][r] = 0.f;
#pragma unroll
    for (int ks = 0; ks < 8; ++ks) {
        const bf16x8v a = *(const LAS bf16x8v*)(VT + (chb + r32) * GM_PITCH + 16 * ks + 8 * hh);
#pragma unroll
        for (int nt = 0; nt < 4; ++nt) {
            const bf16x8v bq = *(const bf16x8v*)(AWS + (size_t)(h * 128 + 32 * nt + r32) * 128 + 16 * ks + 8 * hh);
            acc[nt] = __builtin_amdgcn_mfma_f32_32x32x16_bf16(a, bq, acc[nt], 0, 0, 0);
        }
    }
#pragma unroll
    for (int nt = 0; nt < 4; ++nt) {
        const int p = 32 * nt + r32;
        const float bsv = abs_[h * 128 + p];
#pragma unroll
        for (int g4 = 0; g4 < 4; ++g4) {
            const int ch = chb + 8 * g4 + 4 * hh;
            const u32x2v uu = *(const u32x2v*)(Z + (R0 + p) * NZ + ch);
            u32x2v o;
            o.x = pkbf(bflo(uu.x) * (acc[nt][4 * g4 + 0] + bsv), bfhi(uu.x) * (acc[nt][4 * g4 + 1] + bsv));
            o.y = pkbf(bflo(uu.y) * (acc[nt][4 * g4 + 2] + bsv), bfhi(uu.y) * (acc[nt][4 * g4 + 3] + bsv));
            *(u32x2v*)(MIX + (R0 + p) * DM + ch) = o;
        }
    }
}

typedef const __attribute__((address_space(4))) Args* ArgsP;
__device__ __forceinline__ void phase_prologue(ArgsP ap, LAS unsigned char* lds, int tid, int G, int vcu) {
    const int lane = tid & 63, wave = __builtin_amdgcn_readfirstlane(tid >> 6);
    unsigned char* ws = ap->ws;
    LAS float* COS = (LAS float*)(lds + XTRA_OFF);
    for (int j = tid; j < 2048; j += 512) COS[j] = cospif((float)j * (1.0f / 1024.0f));
    __syncthreads();
    if (vcu < 192) {
        const int lyr = vcu / 96, n = 64 * (vcu % 96) + lane;
        const float* wa = ap->in[I_WADA] + (size_t)lyr * DM * MODW + (size_t)(128 * wave) * MODW + n;
        LAS float* red = (LAS float*)(lds);
        float acc[9];
#pragma unroll
        for (int s9 = 0; s9 < 9; ++s9) acc[s9] = 0.f;
#pragma unroll 1
        for (int kc = 0; kc < 2; ++kc) {
            float wv[64];
#pragma unroll
            for (int kk = 0; kk < 64; ++kk) wv[kk] = wa[(size_t)(64 * kc + kk) * MODW];
            float sil[9];
            sil[0] = silu_f(ap->in[I_CCTX][128 * wave + 64 * kc + lane]);
#pragma unroll
            for (int s9 = 1; s9 < 9; ++s9) sil[s9] = silu_f(ap->in[I_C][(s9 - 1) * DM + 128 * wave + 64 * kc + lane]);
#pragma unroll
            for (int kk = 0; kk < 64; ++kk)
#pragma unroll
                for (int s9 = 0; s9 < 9; ++s9) acc[s9] += __int_as_float(__builtin_amdgcn_readlane(__float_as_int(sil[s9]), kk)) * wv[kk];
        }
#pragma unroll
        for (int s9 = 0; s9 < 9; ++s9) red[(wave * 9 + s9) * 64 + lane] = acc[s9];
        __syncthreads();
        for (int o = tid; o < 576; o += 512) {
            const int s9 = o >> 6, nn = o & 63; float t = 0.f;
#pragma unroll
            for (int w8 = 0; w8 < 8; ++w8) t += red[(w8 * 9 + s9) * 64 + nn];
            const int ncol = 64 * (vcu % 96) + nn;
            ((float*)(ws + WS_MOD))[(size_t)(lyr * 9 + s9) * MODW + ncol] = t + ap->in[I_BADA][lyr * MODW + ncol];
        }
        __syncthreads();
    }
    if (vcu >= 192 && vcu < 224) {
        const int fi = vcu - 192, lyr = fi >> 4, g = (fi >> 2) & 3, qk = fi & 3;
        LAS float* FW = (LAS float*)(lds);
        LAS float* WCt = (LAS float*)(lds + 16384);
        LAS float* WSt = (LAS float*)(lds + 16384 + 64 * 68 * 4);
        const float* fw = ap->in[I_FW] + (size_t)(lyr * 4 + g) * 4096;
        for (int i = tid; i < 4096; i += 512) FW[i] = fw[i];
        __syncthreads();
        {
            const int d = tid & 63, c0 = (tid >> 6) * 8;
#pragma unroll 1
            for (int cc = 0; cc < 8; ++cc) {
                const int c = c0 + cc; float sc = 0.f, ss = 0.f;
                for (int m = 0; m < 64; ++m) { const int j = (m * c) & 63; const float f = FW[m * 64 + d]; sc += COS[32 * j] * f; ss += COS[32 * ((j + 48) & 63)] * f; }
                WCt[d * 68 + c] = sc * 0.125f; WSt[d * 68 + c] = ss * 0.125f;
            }
        }
        __syncthreads();
        {
            const int pq = wave & 1, ksub = wave >> 1;
            const int k = 256 * qk + 64 * ksub + lane;
            const float* wrow = ap->in[I_WIN] + (size_t)lyr * DM * PIN + (size_t)k * PIN + 512 + 64 * g;
            f32x4 wv[16];
#pragma unroll
            for (int i = 0; i < 16; ++i) wv[i] = *(const f32x4*)(wrow + 4 * i);
            const LAS float* Wt = pq ? WSt : WCt;
            bf16* dst = (bf16*)(ws + WS_WIN) + (size_t)lyr * WIN_ROWS * DM + (size_t)(2048 + pq * 256 + g * 64) * DM + k;
#pragma unroll 2
            for (int d = 0; d < 64; ++d) {
                float s = 0.f;
#pragma unroll
                for (int i = 0; i < 16; ++i) { const f32x4 t = *(const LAS f32x4*)(Wt + d * 68 + 4 * i); s += (wv[i][0] * t[0] + wv[i][1] * t[1]) + (wv[i][2] * t[2] + wv[i][3] * t[3]); }
                dst[(size_t)d * DM] = (bf16)f2bf(s);
            }
        }
        __syncthreads();
    }
    LAS float* scr = (LAS float*)(lds + RING_OFF + wave * 16384);
    const int gw = vcu * NWAVES + wave, NGW = G * NWAVES;
    constexpr int N_MOD = 0, N_TR = 11520, N_DFT = 2048, N_DFTC = 256, N_AWS = 256;
    constexpr int NITEMS = N_MOD + N_TR + N_DFT + N_DFTC + N_AWS;
    for (int it = gw; it < NITEMS; it += NGW) {
        asm volatile("" : "+s"(ap));
        ws = ap->ws;
        int r = it;
        r -= N_MOD;
        if (r < N_TR) {
            const int lyr = r / 5760; r %= 5760;
            if (r < 1024) { const int nb = r % 64, kb = r / 64, dc = 32 * nb, sc = dc < 512 ? dc : dc + 256;
                transpose_item(ap->in[I_WIN] + (size_t)lyr * DM * PIN, PIN, (bf16*)(ws + WS_WIN) + (size_t)lyr * WIN_ROWS * DM, DM, 64 * kb, sc, dc, scr, lane); continue; }
            r -= 1024;
            if (r < 512) { const int nb = r % 32, kb = r / 32;
                transpose_item(ap->in[I_WOUT] + (size_t)lyr * DM * DM, DM, (bf16*)(ws + WS_WOUT) + (size_t)lyr * DM * DM, DM, 64 * kb, 32 * nb, 32 * nb, scr, lane); continue; }
            r -= 512;
            if (r < 2816) { const int nb = r % 176, kb = r / 176, sc = 32 * nb, ch = sc < DFF ? sc : sc - DFF, dr = 256 * (ch >> 7) + (ch & 127) + (sc < DFF ? 0 : 128);
                transpose_item(ap->in[I_WGU] + (size_t)lyr * DM * NGU, NGU, (bf16*)(ws + WS_WGU) + (size_t)lyr * NGU * DM, DM, 64 * kb, sc, dr, scr, lane); continue; }
            r -= 2816;
            { const int nb = r % 32, kb = r / 32;
                transpose_item(ap->in[I_WDOWN] + (size_t)lyr * DFF * DM, DM, (bf16*)(ws + WS_WDN) + (size_t)lyr * DM * DFF, DFF, 64 * kb, 32 * nb, 32 * nb, scr, lane); continue; }
        }
        r -= N_TR;
        if (r < N_DFT) {
            const int k = r; bf16* row = (bf16*)(ws + WS_DFT) + (size_t)k * 4096;
            const float sc = 0.02209708691207961f;
#pragma unroll 1
            for (int st = 0; st < 4; ++st) {
                const int l0 = 8 * (lane + 64 * st); float c[8], s[8];
#pragma unroll
                for (int e = 0; e < 8; ++e) { const int idx = (k * (l0 + e)) & 2047; c[e] = COS[idx] * sc; s[e] = -COS[(idx + 1536) & 2047] * sc; }
                v4u oc, os; oc.x = pk2(c[0], c[1]); oc.y = pk2(c[2], c[3]); oc.z = pk2(c[4], c[5]); oc.w = pk2(c[6], c[7]);
                os.x = pk2(s[0], s[1]); os.y = pk2(s[2], s[3]); os.z = pk2(s[4], s[5]); os.w = pk2(s[6], s[7]);
                *(v4u*)(row + l0) = oc; *(v4u*)(row + 2048 + l0) = os;
            }
            continue;
        }
        r -= N_DFT;
        if (r < N_DFTC) {
            const int k = r; bf16* row = (bf16*)(ws + WS_DFT256) + (size_t)k * 512;
            const int l0 = 8 * (lane & 31); const bool sn = lane >= 32; float v[8];
#pragma unroll
            for (int e = 0; e < 8; ++e) { const int idx = (k * (l0 + e) * 8) & 2047; v[e] = sn ? -COS[(idx + 1536) & 2047] * 0.0625f : COS[idx] * 0.0625f; }
            v4u o; o.x = pk2(v[0], v[1]); o.y = pk2(v[2], v[3]); o.z = pk2(v[4], v[5]); o.w = pk2(v[6], v[7]);
            *(v4u*)(row + (sn ? 256 : 0) + l0) = o;
            continue;
        }
        r -= N_DFTC;
        {
            const size_t i0 = (size_t)r * 512 + lane * 8;
            const f32x4 x0 = *(const f32x4*)(ap->in[I_AWS] + i0), x1 = *(const f32x4*)(ap->in[I_AWS] + i0 + 4);
            v4u o; o.x = pk2(x0[0], x0[1]); o.y = pk2(x0[2], x0[3]); o.z = pk2(x1[0], x1[1]); o.w = pk2(x1[2], x1[3]);
            *(v4u*)((bf16*)(ws + WS_AWS) + i0) = o;
        }
    }
}

__global__ void __launch_bounds__(NWAVES * 64, 2) mega_fwd(Args args) {
    extern __shared__ __attribute__((aligned(16))) unsigned char lds_raw[];
    LAS unsigned char* lds = (LAS unsigned char*)lds_raw;
    volatile LAS unsigned* MISC = (volatile LAS unsigned*)(lds + MISC_OFF);
    const int tid0 = threadIdx.x;
    const int G0 = gridDim.x, bx0 = blockIdx.x;
    ArgsP ap = (ArgsP)__builtin_amdgcn_kernarg_segment_ptr();
    unsigned char* ws = ap->ws;
    gu32* ctl = (gu32*)(ws + WS_CTL);
    for (int u = tid0; u < (LDS_BYTES - LDSCTL_OFF) / 4; u += NWAVES * 64) ((LAS unsigned*)(lds + LDSCTL_OFF))[u] = 0u;
    __syncthreads();
    const int ph_lo = ap->ph_lo, ph_hi = ap->ph_hi;
    const bool multi = (ph_hi - ph_lo) > 1;
    XcdBarrier bar; bar.bar = (unsigned*)(ctl + CW_BAR); bar.x = 0; bar.st = nullptr;
    if (multi) bar = xcd_barrier_post((unsigned*)(ctl + CW_BAR), MISC + 8);


#ifdef PROBE_MASK
    unsigned long long probe_acc = 0, probe_t0 = __builtin_amdgcn_s_memrealtime();
#endif
    for (int ph = ph_lo; ph < ph_hi; ++ph) {
        asm volatile("" : "+s"(ap));
        int tid = tid0, G = G0, bx = bx0;
        asm volatile("" : "+v"(tid)); asm volatile("" : "+s"(G)); asm volatile("" : "+s"(bx));
        const int lane = tid & 63, wave = __builtin_amdgcn_readfirstlane(tid >> 6);
        const int vcu = (G % 8 == 0) ? (bx % 8) * (G / 8) + bx / 8 : bx;
        const int gw = vcu * NWAVES + wave, NGW = G * NWAVES;
        ws = ap->ws;
        bf16* const H = (bf16*)(ws + WS_H); bf16* const Zb = (bf16*)(ws + WS_Z); bf16* const MIX = (bf16*)(ws + WS_MIX); bf16* const ACT = (bf16*)(ws + WS_ACT);
        float* const MOD = (float*)(ws + WS_MOD); float* const XB = ap->out; float* const EDGE = (float*)(ws + WS_EDGE);
        ctl = (gu32*)(ws + WS_CTL);
        if (ph == 0) {
#ifndef NO_P0
            phase_prologue(ap, lds, tid, G, vcu);
#endif
        } else if (ph == 1) {
            ln_pass(0, 0, ap->in[I_XP], ap->in[I_XS], XB, MOD, nullptr, nullptr, H, gw, NGW, lane);
        } else {
            const int l = (ph - 2) >> 3, sub = (ph - 2) & 7;
            const float* modl = MOD + (size_t)l * 9 * MODW;
            if (sub == 0) {
                const bf16* base = (const bf16*)(ws + WS_WIN) + (size_t)l * WIN_ROWS * DM;
                pg8::Gemm g{base, base, 0, 0, DM};
                SchedP1 S{G, bx, l == 0 ? 20 : 10};
                EpiZ E{Zb, (bf16*)(ws + WS_PQL), (bf16*)(ws + WS_PQC), XB + (size_t)MTOK * DM, XB + (size_t)MTOK * DM + (size_t)16 * 2 * 256 * 512, l, l == 0 ? 20 : 10};
#ifndef NO_G1
                pg8::gemm_phase<EpiZ, SchedP1, PG8_ALIGN, PG8_SP2>(lds + RING_OFF, g, S, E);
#endif
            } else if (sub == 1) {
                for (;;) {
                    asm volatile("" : "+s"(ap));
                    int tidu = tid; asm volatile("" : "+v"(tidu));
                    unsigned char* wsq = ap->ws;
                    __syncthreads();
                    if (tid == 0) MISC[4] = __hip_atomic_fetch_add((gu32*)(wsq + WS_CTL) + CW_QUEUE + 64 * l, 1u, __ATOMIC_RELAXED, __HIP_MEMORY_SCOPE_AGENT);
                    __syncthreads();
                    const int idx = (int)MISC[4];
                    if (idx >= 880) break;
                    if (idx < 64 || (idx >= 576 && idx < 592)) {
                        const bool lat = idx < 64; const int j = lat ? idx : idx - 576;
                        pg8::Gemm g{lat ? (const bf16*)(wsq + WS_DFT) : (const bf16*)(wsq + WS_DFT256), lat ? (const bf16*)(wsq + WS_PQL) : (const bf16*)(wsq + WS_PQC), 0, 0, lat ? 4096 : 512};
                        OneUnit S{{lat ? (j & 7) : 0, lat ? (j >> 3) : j}};
                        EpiFourier E{(bf16*)(wsq + WS_MIX), lat ? MCTX : 0, lat ? 2048 : 256};
#ifndef NO_FO
                        pg8::gemm_phase<EpiFourier, OneUnit, PG8_ALIGN, PG8_SP2>(lds + RING_OFF, g, S, E);
#endif
                    } else if (idx < 576) {
                        const int u = idx - 64;
#ifndef NO_AL
                        attn_unit<true>(lds + RING_OFF, (const bf16*)(wsq + WS_Z), ap->in[I_CK] + (size_t)l * 512 * 512, ap->in[I_CV] + (size_t)l * 512 * 512, ap->in[I_RPB] + (size_t)l * 8 * 465,
                                        (bf16*)(wsq + WS_MIX), u >> 6, (u >> 3) & 7, u & 7, tidu);
#endif
                    } else if (idx < 720) {
                        const int u = idx - 592;
#ifndef NO_AC
                        attn_unit<false>(lds + RING_OFF, (const bf16*)(wsq + WS_Z), nullptr, nullptr, nullptr, (bf16*)(wsq + WS_MIX), u >> 3, u & 7, 0, tidu);
#endif
                    } else {
#ifndef NO_GM
                        gmlp_unit(lds + RING_OFF, (const bf16*)(wsq + WS_Z), (const bf16*)(wsq + WS_AWS) + (size_t)l * 4 * 128 * 128, ap->in[I_ABS] + (size_t)l * 4 * 128, (bf16*)(wsq + WS_MIX), idx - 720, tidu);
#endif
                    }
                }
            } else if (sub == 2 || sub == 6) {
                const bool dn = sub == 6;
                pg8::Gemm g{dn ? (const bf16*)ACT : (const bf16*)MIX, dn ? (const bf16*)(ws + WS_WDN) + (size_t)l * DM * DFF : (const bf16*)(ws + WS_WOUT) + (size_t)l * DM * DM, 0, 0, dn ? DFF : DM};
                pg8::StaticOrder S; S.init(MTOK, DM, G, bx);
                const bool fromin = (!dn && l == 0);
                EpiRes E{fromin ? ap->in[I_XP] : (const float*)XB, fromin ? ap->in[I_XS] : (const float*)(XB + (size_t)MCTX * DM), XB, modl + (dn ? 5120 : 2048)};
#ifndef NO_G2
                pg8::gemm_phase<EpiRes, pg8::StaticOrder, PG8_ALIGN, PG8_SP2>(lds + RING_OFF, g, S, E);
#endif
            } else if (sub == 3 || sub == 7) {
                const bool second = sub == 7;
                ln_pass(second ? 2 : 1, l, nullptr, nullptr, XB, MOD, ap->in[second ? I_LN2G : I_LN1G] + (size_t)l * DM, ap->in[second ? I_LN2B : I_LN1B] + (size_t)l * DM, H, gw, NGW, lane);
            } else if (sub == 4) {
                pg8::Gemm g{(const bf16*)H, (const bf16*)(ws + WS_WGU) + (size_t)l * NGU * DM, 0, 0, DM};
                pg8::StaticOrder S; S.init(MTOK, NGU, G, bx);
                EpiConv E{ACT, EDGE, ap->in[I_CONVW] + (size_t)l * 3 * DFF, ap->in[I_CONVB] + (size_t)l * DFF, (PG8_LAS float*)(lds + XTRA_OFF)};
#ifndef NO_G3
                pg8::gemm_phase<EpiConv, pg8::StaticOrder, true, PG8_SP2>(lds + RING_OFF, g, S, E);
#endif
            } else {
                const float* cw = ap->in[I_CONVW] + (size_t)l * 3 * DFF; const float* cb = ap->in[I_CONVB] + (size_t)l * DFF;
                for (int it = gw; it < 160; it += NGW) {
                    const int pm = it >> 1, bot = it & 1;
                    const bool first = pm < 16 || ((pm - 16) & 7) == 0, last = pm < 16 || ((pm - 16) & 7) == 7;
                    const float* e = EDGE + (size_t)pm * 6 * DFF;
                    const int R = pm * 256 + (bot ? 255 : 0);
                    for (int ch = lane; ch < DFF; ch += 64) {
                        float gm, g0, gp, uu;
                        if (!bot) { gm = first ? 0.f : e[-(ptrdiff_t)(6 * DFF) + 3 * DFF + ch]; g0 = e[ch]; gp = e[DFF + ch]; uu = e[2 * DFF + ch]; }
                        else { gm = e[4 * DFF + ch]; g0 = e[3 * DFF + ch]; gp = last ? 0.f : e[6 * DFF + ch]; uu = e[5 * DFF + ch]; }
                        const float gc = cb[ch] + cw[ch] * gm + cw[DFF + ch] * g0 + cw[2 * DFF + ch] * gp;
                        ACT[(size_t)R * DFF + ch] = (bf16)f2bf(silu_f(gc) * uu);
                    }
                }
            }
        }
        if (ph + 1 < ph_hi) xcd_barrier(bar);
#ifdef PROBE_MASK
        { const unsigned long long t1 = __builtin_amdgcn_s_memrealtime(); if ((PROBE_MASK >> ph) & 1) probe_acc += t1 - probe_t0; probe_t0 = t1; }
#endif
    }
#ifdef PROBE_MASK
    if (bx0 == 0) { const unsigned long long tend = __builtin_amdgcn_s_memrealtime() + probe_acc; while (__builtin_amdgcn_s_memrealtime() < tend) __builtin_amdgcn_s_sleep(8); }
#endif
}

#ifndef MK_PER_PHASE
#define MK_PER_PHASE 0
#endif
extern "C" void kernel_launch(void* const* d_in, const int* in_sizes, int n_in, void* d_out, int out_size, void* d_ws, size_t ws_size, hipStream_t stream) {
    static int grid = 0;
    if (grid == 0) {
        if (n_in != 22 || ws_size < WS_END || out_size != MTOK * DM + 2 * 16 * 2 * 256 * 512) { fprintf(stderr, "kernel_launch: unexpected problem (n_in %d, out %d, ws %zu)\n", n_in, out_size, ws_size); grid = -1; return; }
        int dev = 0, cus = 0;
        if (hipGetDevice(&dev) != hipSuccess || hipDeviceGetAttribute(&cus, hipDeviceAttributeMultiprocessorCount, dev) != hipSuccess) { grid = -1; return; }
        if (hipFuncSetAttribute((const void*)mega_fwd, hipFuncAttributeMaxDynamicSharedMemorySize, LDS_BYTES) != hipSuccess) { fprintf(stderr, "kernel_launch: hipFuncSetAttribute failed\n"); grid = -1; return; }
        (void)hipGetLastError();
        grid = cus;
    }
    if (grid < 0) return;
    (void)hipMemsetAsync((char*)d_ws + WS_CTL, 0, CTL_ZERO_BYTES, stream);
    Args a{};
    for (int i = 0; i < 22; ++i) a.in[i] = (const float*)d_in[i];
    a.out = (float*)d_out; a.ws = (unsigned char*)d_ws;
#if MK_PER_PHASE
    for (int ph = 0; ph < NPHASE; ++ph) { a.ph_lo = ph; a.ph_hi = ph + 1; hipLaunchKernelGGL(mega_fwd, dim3(grid), dim3(NWAVES * 64), LDS_BYTES, stream, a); }
#else
    a.ph_lo = 0; a.ph_hi = NPHASE;
    hipLaunchKernelGGL(mega_fwd, dim3(grid), dim3(NWAVES * 64), LDS_BYTES, stream, a);
#endif
}
```
